# Optimizing an MI355X kernel written in HIP

```python
import functools
import jax, jax.numpy as jnp
from jax import lax
import numpy as np

D_MODEL = 1024
BATCH = 8
SEQ = 8192
DEPTH = 1
DEC_BATCH = 8
DEC_SEQ = 32
PAST_LEN = 4096

CHUNK = 64
H_A = 4
DK_A = 128
DV_A = 256
GATE_RANK = 16
GATE_TAU = 16.0
H_B = 8
HD_B = 64
BAND_CHUNKS = 8
REL_CLIP = 128
D_FF = 2816
CONV_W = 3
PLE_DIM = 256
EPS = 1e-6

QK_A = H_A * DK_A
V_A = H_A * DV_A
W_B = H_B * HD_B
REACH = BAND_CHUNKS * CHUNK
IN_SIZES = (QK_A, QK_A, V_A, V_A, GATE_RANK, W_B, W_B, W_B, D_MODEL, D_MODEL)
N_IN = sum(IN_SIZES)

kernel_name = 'hybrid_gla_chunkband_stream_step'


def rms_norm(x, g):
    xf = x.astype(jnp.float32)
    y = xf * lax.rsqrt(jnp.mean(xf * xf, axis=-1, keepdims=True) + EPS) * g.astype(jnp.float32)
    return y.astype(x.dtype)


def split_cols(z):
    idx = np.cumsum(IN_SIZES)[:-1].tolist()
    return jnp.split(z, idx, axis=-1)


def gla_branch(q, k, v, r, alr, w_a2, b_a2, g_gla, s0, block):
    B, T, _ = q.shape
    n = T // block
    f32 = jnp.float32
    log_a = jax.nn.log_sigmoid((alr @ w_a2 + b_a2).astype(f32)) / GATE_TAU

    def to_blocks(t, e):
        return t.astype(f32).reshape(B, n, block, H_A, e).transpose(1, 0, 3, 2, 4)

    qb = to_blocks(q, DK_A) * DK_A ** -0.5
    kb = to_blocks(k, DK_A)
    vb = to_blocks(v, DV_A)
    ab = to_blocks(log_a, DK_A)
    mask = jnp.tril(jnp.ones((block, block), dtype=bool))[:, :, None]

    def step(S, inp):
        qi, ki, vi, ai = inp
        b = jnp.cumsum(ai, axis=2)
        decay = jnp.exp(jnp.where(mask, b[:, :, :, None, :] - b[:, :, None, :, :], -jnp.inf))
        scores = jnp.einsum('bhic,bhjc,bhijc->bhij', qi, ki, decay)
        o = (jnp.einsum('bhij,bhjv->bhiv', scores, vi)
             + jnp.einsum('bhic,bhcv->bhiv', qi * jnp.exp(b), S))
        bl = b[:, :, -1]
        S = (jnp.exp(bl)[..., None] * S
             + jnp.einsum('bhjc,bhjv->bhcv', ki * jnp.exp(bl[:, :, None] - b), vi))
        return S, o

    s_fin, o = lax.scan(step, s0.astype(f32), (qb, kb, vb, ab))
    o = o.transpose(1, 0, 3, 2, 4).reshape(B, T, H_A, DV_A)
    o = o * lax.rsqrt(jnp.mean(o * o, axis=-1, keepdims=True) + EPS)
    o = o.reshape(B, T, V_A) * g_gla.astype(f32)
    o = o.astype(q.dtype) * jax.nn.silu(r)
    return o, s_fin.astype(s0.dtype)


def band_attend(q, k, v, q_pos, k_pos, rel_bias):
    s = jnp.einsum('bqhe,bkhe->bhqk', q, k).astype(jnp.float32) * HD_B ** -0.5
    rel = jnp.clip(q_pos[:, None] - k_pos[None, :], -REL_CLIP, REL_CLIP) + REL_CLIP
    bias = rel_bias.astype(jnp.float32)[:, rel]
    qc = q_pos // CHUNK
    kc = k_pos // CHUNK
    vis = ((k_pos[None, :] >= 0) & (kc[None, :] <= qc[:, None])
           & (kc[None, :] >= qc[:, None] - BAND_CHUNKS))
    s = jnp.where(vis, s + bias, -jnp.inf)
    p = jax.nn.softmax(s, axis=-1)
    return jnp.einsum('bhqk,bkhe->bqhe', p.astype(v.dtype), v)


def attn_prompt(q, k, v, rel_bias):
    B, T, _ = q.shape
    qh = q.reshape(B, T, H_B, HD_B)
    kh = k.reshape(B, T, H_B, HD_B)
    vh = v.reshape(B, T, H_B, HD_B)
    pad = ((0, 0), (REACH, 0), (0, 0), (0, 0))
    kp = jnp.pad(kh, pad)
    vp = jnp.pad(vh, pad)

    def one_chunk(c):
        start = c * CHUNK
        qc = lax.dynamic_slice_in_dim(qh, start, CHUNK, axis=1)
        kc = lax.dynamic_slice_in_dim(kp, start, REACH + CHUNK, axis=1)
        vc = lax.dynamic_slice_in_dim(vp, start, REACH + CHUNK, axis=1)
        q_pos = start + jnp.arange(CHUNK, dtype=jnp.int32)
        k_pos = start - REACH + jnp.arange(REACH + CHUNK, dtype=jnp.int32)
        return band_attend(qc, kc, vc, q_pos, k_pos, rel_bias)

    o = lax.map(one_chunk, jnp.arange(T // CHUNK, dtype=jnp.int32))
    o = o.transpose(1, 0, 2, 3, 4).reshape(B, T, W_B)
    keep = min(REACH, T)
    return o, kh[:, T - keep:], vh[:, T - keep:]


def attn_sample(q, k, v, rel_bias, cache_k, cache_v):
    B, T, _ = q.shape
    qh = q.reshape(B, T, H_B, HD_B)
    kh = k.reshape(B, T, H_B, HD_B)
    vh = v.reshape(B, T, H_B, HD_B)
    lc = cache_k.shape[1]
    k_all = jnp.concatenate([cache_k.astype(kh.dtype), kh], axis=1)
    v_all = jnp.concatenate([cache_v.astype(vh.dtype), vh], axis=1)
    k_pos = jnp.concatenate([PAST_LEN - lc + jnp.arange(lc, dtype=jnp.int32),
                             PAST_LEN + jnp.arange(T, dtype=jnp.int32)])
    q_pos = PAST_LEN + jnp.arange(T, dtype=jnp.int32)
    o = band_attend(qh, k_all, v_all, q_pos, k_pos, rel_bias)
    return o.reshape(B, T, W_B), kh, vh


def conv_ffn(h, conv_s0, w_up, conv_w, conv_b, w_down):
    T = h.shape[1]
    a, g = jnp.split(h @ w_up, [D_FF], axis=-1)
    gx = jnp.concatenate([conv_s0.astype(g.dtype), g], axis=1)
    gc = conv_b + sum(conv_w[i] * gx[:, i:i + T] for i in range(CONV_W))
    y = (jax.nn.gelu(gc) * a) @ w_down
    return y, gx[:, T:]


def layer_forward(x, pe, attn_fn, gla_s0, gla_block, conv_s0, w):
    (g_pre_mix, w_in, w_a2, b_a2, g_gla, rel_bias, w_br_a, w_br_b, w_out, g_post_mix,
     g_pre_ffn, w_up, conv_w, conv_b, w_down, g_post_ffn,
     g_pre_ple, w_ple_gate, w_ple, g_post_ple) = w
    h = rms_norm(x, g_pre_mix)
    qa, ka, va, ra, alr, qb, kb, vb, ga, gb = split_cols(h @ w_in)
    oa, s_gla = gla_branch(qa, ka, va, ra, alr, w_a2, b_a2, g_gla, gla_s0, gla_block)
    ob, k_rows, v_rows = attn_fn(qb, kb, vb, rel_bias)
    mix = (jax.nn.sigmoid(ga) * (oa @ w_br_a) + jax.nn.sigmoid(gb) * (ob @ w_br_b)) @ w_out
    x = x + rms_norm(mix, g_post_mix)
    f, conv_new = conv_ffn(rms_norm(x, g_pre_ffn), conv_s0, w_up, conv_w, conv_b, w_down)
    x = x + rms_norm(f, g_post_ffn)
    gate = jax.nn.sigmoid(rms_norm(x, g_pre_ple) @ w_ple_gate)
    x = x + rms_norm(gate * (pe @ w_ple), g_post_ple)
    return x, k_rows, v_rows, s_gla, conv_new


def setup_inputs(seed: int = 0) -> dict:
    key = jax.random.key(seed)
    ks = iter(jax.random.split(key, 32))
    nrm = lambda shape, scale: scale * jax.random.normal(next(ks), shape, jnp.float32)
    gain = lambda shape: 1.0 + nrm(shape, 0.01)
    lc = min(REACH, PAST_LEN)
    return {
        'x_prompt': nrm((BATCH, SEQ, D_MODEL), 1.0),
        'x_sample': nrm((DEC_BATCH, DEC_SEQ, D_MODEL), 1.0),
        'cache_attn_k': nrm((DEPTH, DEC_BATCH, lc, H_B, HD_B), 1.0),
        'cache_attn_v': nrm((DEPTH, DEC_BATCH, lc, H_B, HD_B), 1.0),
        'state_gla': nrm((DEPTH, DEC_BATCH, H_A, DK_A, DV_A), 1.0),
        'state_conv': nrm((DEPTH, DEC_BATCH, CONV_W - 1, D_FF), 1.0),
        'p_prompt': nrm((DEPTH, BATCH, SEQ, PLE_DIM), 1.0),
        'p_sample': nrm((DEPTH, DEC_BATCH, DEC_SEQ, PLE_DIM), 1.0),
        'g_pre_mix': gain((DEPTH, D_MODEL)),
        'w_in': nrm((DEPTH, D_MODEL, N_IN), D_MODEL ** -0.5),
        'w_a2': nrm((DEPTH, GATE_RANK, QK_A), GATE_RANK ** -0.5),
        'b_a2': nrm((DEPTH, QK_A), 0.1),
        'g_gla': gain((DEPTH, V_A)),
        'rel_bias': nrm((DEPTH, H_B, 2 * REL_CLIP + 1), 0.1),
        'w_br_a': nrm((DEPTH, V_A, D_MODEL), V_A ** -0.5),
        'w_br_b': nrm((DEPTH, W_B, D_MODEL), W_B ** -0.5),
        'w_out': nrm((DEPTH, D_MODEL, D_MODEL), D_MODEL ** -0.5),
        'g_post_mix': gain((DEPTH, D_MODEL)),
        'g_pre_ffn': gain((DEPTH, D_MODEL)),
        'w_up': nrm((DEPTH, D_MODEL, 2 * D_FF), D_MODEL ** -0.5),
        'conv_w': nrm((DEPTH, CONV_W, D_FF), CONV_W ** -0.5),
        'conv_b': nrm((DEPTH, D_FF), 0.02),
        'w_down': nrm((DEPTH, D_FF, D_MODEL), D_FF ** -0.5),
        'g_post_ffn': gain((DEPTH, D_MODEL)),
        'g_pre_ple': gain((DEPTH, D_MODEL)),
        'w_ple_gate': nrm((DEPTH, D_MODEL, D_MODEL), D_MODEL ** -0.5),
        'w_ple': nrm((DEPTH, PLE_DIM, D_MODEL), PLE_DIM ** -0.5),
        'g_post_ple': gain((DEPTH, D_MODEL)),
    }


def reference(x_prompt, x_sample, cache_attn_k, cache_attn_v, state_gla, state_conv,
              p_prompt, p_sample, g_pre_mix, w_in, w_a2, b_a2, g_gla, rel_bias,
              w_br_a, w_br_b, w_out, g_post_mix, g_pre_ffn, w_up, conv_w, conv_b,
              w_down, g_post_ffn, g_pre_ple, w_ple_gate, w_ple, g_post_ple):
    bp = x_prompt.shape[0]
    ts = x_sample.shape[1]
    yp, ys = x_prompt, x_sample
    kp_l, vp_l, sp_l, cp_l, ks_l, vs_l, ss_l, cs_l = [], [], [], [], [], [], [], []
    for l in range(DEPTH):
        w = (g_pre_mix[l], w_in[l], w_a2[l], b_a2[l], g_gla[l], rel_bias[l], w_br_a[l],
             w_br_b[l], w_out[l], g_post_mix[l], g_pre_ffn[l], w_up[l], conv_w[l],
             conv_b[l], w_down[l], g_post_ffn[l], g_pre_ple[l], w_ple_gate[l], w_ple[l],
             g_post_ple[l])
        yp, kp, vp, sp, cp = layer_forward(
            yp, p_prompt[l], attn_prompt,
            jnp.zeros((bp, H_A, DK_A, DV_A), jnp.float32), CHUNK,
            jnp.zeros((bp, CONV_W - 1, D_FF), yp.dtype), w)
        ys, ks, vs, ss, cs = layer_forward(
            ys, p_sample[l],
            functools.partial(attn_sample, cache_k=cache_attn_k[l], cache_v=cache_attn_v[l]),
            state_gla[l], ts, state_conv[l], w)
        kp_l.append(kp); vp_l.append(vp); sp_l.append(sp); cp_l.append(cp)
        ks_l.append(ks); vs_l.append(vs); ss_l.append(ss); cs_l.append(cs)
    return (yp, ys,
            jnp.stack(kp_l), jnp.stack(vp_l), jnp.stack(sp_l), jnp.stack(cp_l),
            jnp.stack(ks_l), jnp.stack(vs_l), jnp.stack(ss_l), jnp.stack(cs_l))
```

```cpp
#include <hip/hip_runtime.h>
#include <hip/hip_cooperative_groups.h>
#include <cstdio>
#include <cstdint>
namespace cg = cooperative_groups;

#define LAS __attribute__((address_space(3)))
typedef unsigned short bf16_t;
typedef short bf16x8 __attribute__((ext_vector_type(8)));
typedef float f32x4 __attribute__((ext_vector_type(4)));
typedef float f32x2 __attribute__((ext_vector_type(2)));
typedef unsigned u32x4 __attribute__((ext_vector_type(4)));
typedef unsigned u32x2 __attribute__((ext_vector_type(2)));
typedef __bf16 bf16x2_t __attribute__((ext_vector_type(2)));

constexpr int DM = 1024, TP = 65536, TSMP = 256, TT = TP + TSMP, SEQ = 8192;
constexpr int DFF = 2816;
constexpr int ZP = 6656;
constexpr int ZQA = 0, ZKA = 512, ZVA = 1024, ZRA = 2048, ZQB = 3072, ZKB = 3584, ZVB = 4096, ZGA = 4608, ZGB = 5632;
constexpr float EPS = 1e-6f;
constexpr float LOG2E = 1.4426950408889634f;
constexpr size_t O_YP = 0, O_YS = 67108864, O_KP = 67371008, O_VP = 69468160, O_SP = 71565312, O_CP = 72613888,
                 O_KS = 72658944, O_VS = 72790016, O_SS = 72921088, O_CS = 73969664;
constexpr size_t MiB = 1u << 20;
constexpr size_t WS_WIN = 0, WS_WBRA = 14 * MiB, WS_WBRB = 16 * MiB, WS_WOUT = 17 * MiB, WS_WUP = 19 * MiB, WS_WDN = 30 * MiB,
                 WS_WPG = 36 * MiB, WS_WPLE = 38 * MiB;
constexpr size_t WS_Z = 40 * MiB;
constexpr size_t WS_B2 = 876 * MiB;
constexpr size_t WS_SSQ = 1005 * MiB;
constexpr size_t WS_CTL = 1010 * MiB;
constexpr size_t WS_NEED = 1011 * MiB;
constexpr size_t WS_B3 = WS_Z;
constexpr size_t WS_ACT = WS_Z + 130 * MiB;
constexpr size_t WS_PB = WS_Z + 490 * MiB;
constexpr size_t WS_E = WS_Z + 530 * MiB;
constexpr size_t YO_B1 = 0;
constexpr size_t YO_PS = 130 * MiB;
constexpr size_t YO_DL = 164 * MiB;
constexpr size_t YO_ALR = 168 * MiB;

__device__ __forceinline__ float bf2f(bf16_t b) { return __uint_as_float(((unsigned)b) << 16); }
__device__ __forceinline__ unsigned pk2(float lo, float hi) { f32x2 v = {lo, hi}; bf16x2_t b = __builtin_convertvector(v, bf16x2_t); return __builtin_bit_cast(unsigned, b); }
__device__ __forceinline__ float lo2f(unsigned u) { return __uint_as_float(u << 16); }
__device__ __forceinline__ float hi2f(unsigned u) { return __uint_as_float(u & 0xffff0000u); }
__device__ __forceinline__ float fsigmoid(float x) { return __builtin_amdgcn_rcpf(1.0f + __builtin_amdgcn_exp2f(-x * LOG2E)); }
__device__ __forceinline__ float wave_sum(float v) {
#pragma unroll
    for (int o = 1; o < 64; o <<= 1) v += __shfl_xor(v, o);
    return v;
}
#define LDS_WAIT() asm volatile("s_waitcnt lgkmcnt(0)" ::: "memory")
#define BLOCK_SYNC() __syncthreads()

namespace pg8 {
constexpr int BM = 256, BK = 64, HALF = 128, HTB = HALF * BK * 2, STAGE_BYTES = 8 * HTB, NXCD = 8, WGM = 8;
__host__ __device__ __forceinline__ int lds_byte(int r, int c) { const int st = (r >> 4) * 2 + (c >> 5), rr = r & 15, cc = c & 31, ob = rr * 64 + cc * 2; return st * 1024 + (ob ^ (((ob >> 9) & 1) << 5)); }
__host__ __device__ __forceinline__ void stage_rc(int b, int& R, int& C) { const int st = b / 1024, sb = b % 1024, swz = sb ^ (((sb >> 9) & 1) << 5); R = (st >> 1) * 16 + swz / 64; C = (st & 1) * 32 + (swz % 64) / 2; }
__host__ __device__ __forceinline__ int perm32(int rho) { const int n = rho >> 4, i = rho & 15; return 8 * (i >> 2) + 4 * n + (i & 3); }

struct Unit { int pm, pn; };
struct Gemm { const bf16_t* A; const bf16_t* Bt; int lda, K, amode; };

__device__ __forceinline__ long a_row0(int amode, int pm) {
    if (amode == 0) return (long)pm * 256;
    if (pm >= 264) return (long)TP;
    const int b = pm / 33, j = pm - b * 33;
    return (long)b * SEQ + 254 * j - 2;
}

struct StaticOrder {
    int nM, nN, nwg, G, c;
    __device__ void init(int nM_, int nN_, int G_, int c_) { nM = nM_; nN = nN_; nwg = nM * nN; G = G_; c = c_; }
    __device__ bool next(int i, Unit& u) const {
        const long L = (long)i * G + c; if (L >= nwg) return false;
        int wgid = (int)L; { const int q = nwg / NXCD, r = nwg % NXCD, xcd = wgid % NXCD, off = wgid / NXCD; wgid = (xcd < r ? xcd * (q + 1) : r * (q + 1) + (xcd - r) * q) + off; }
        const int nig = WGM * nN, gid = wgid / nig, fm = gid * WGM, gsz = (nM - fm) < WGM ? (nM - fm) : WGM;
        u.pm = fm + ((wgid % nig) % gsz); u.pn = (wgid % nig) / gsz; return true;
    }
};

template <class Epi>
__device__ __forceinline__ void gemm_phase(LAS unsigned char* lds, const Gemm g, const StaticOrder& S, const Epi& E) {
    int tid_ = threadIdx.x; asm volatile("" : "+v"(tid_));
    const int tid = tid_, wid = __builtin_amdgcn_readfirstlane(tid >> 6), lane = tid & 63, wr = wid >> 2, wc = wid & 3, fr = lane & 15, fq = lane >> 4;
    const int K = g.K, nt = K / BK, lda = g.lda;
    unsigned voffA[2], voffB[2];
#pragma unroll
    for (int i = 0; i < 2; ++i) { int R, C; stage_rc(tid * 16 + i * 8192, R, C); const int Rb = (R & ~31) + perm32(R & 31);
        voffA[i] = (unsigned)(R * lda + C) * 2u; voffB[i] = (unsigned)(Rb * K + C) * 2u; }
    const size_t kstep = (size_t)(BK * 2);
    const size_t hstepA = (size_t)HALF * lda * 2, hstepB = (size_t)HALF * K * 2;
    const size_t tstepB = 2 * hstepB;
    const unsigned ldsw = (unsigned)wid * 1024u;
    const int aoff = lds_byte(wr * 64 + fr, fq * 8), boff = lds_byte(wc * 32 + fr, fq * 8);
#define PG8_SA(b, h) (((b) * 2 + (h)) * HTB)
#define PG8_SB(b, h) ((4 + (b) * 2 + (h)) * HTB)
#define PG8_STAGE(bufoff, gbase, voff) do { _Pragma("unroll") for (int _i = 0; _i < 2; ++_i) \
        __builtin_amdgcn_global_load_lds((const unsigned*)((const char*)(gbase) + (voff)[_i]), (LAS unsigned*)(lds + (bufoff) + ldsw + _i * 8192), 16, 0, 0); } while (0)
#define PG8_LDA(dst, b, h) do { _Pragma("unroll") for (int m = 0; m < 4; ++m) _Pragma("unroll") for (int k = 0; k < 2; ++k) dst[m][k] = *(const LAS bf16x8*)(lds + PG8_SA(b, h) + aoff + m * 2048 + k * 1024); } while (0)
#define PG8_LDB(dst, b, h) do { _Pragma("unroll") for (int n = 0; n < 2; ++n) _Pragma("unroll") for (int k = 0; k < 2; ++k) dst[n][k] = *(const LAS bf16x8*)(lds + PG8_SB(b, h) + boff + n * 2048 + k * 1024); } while (0)
#define PG8_MMA(ai, bj, At, Bt) do { __builtin_amdgcn_s_setprio(1); _Pragma("unroll") for (int m = 0; m < 4; ++m) _Pragma("unroll") for (int n = 0; n < 2; ++n) _Pragma("unroll") for (int k = 0; k < 2; ++k) \
        acc[ai][bj][m][n] = __builtin_amdgcn_mfma_f32_16x16x32_bf16(Bt[n][k], At[m][k], acc[ai][bj][m][n], 0, 0, 0); __builtin_amdgcn_s_setprio(0); } while (0)
#define PG8_WAIT_V(n) asm volatile("s_waitcnt vmcnt(" #n ")" ::: "memory")
#define PG8_WAIT_L(n) asm volatile("s_waitcnt lgkmcnt(" #n ")" ::: "memory")
#define PG8_BAR __builtin_amdgcn_s_barrier()
#define PG8_SCHED __builtin_amdgcn_sched_barrier(0)
    Unit cur, nxt; int ui = 0;
    if (!S.next(0, cur)) return;
    f32x4 acc[2][2][4][2];
#pragma unroll
    for (int a = 0; a < 2; ++a)
#pragma unroll
        for (int b = 0; b < 2; ++b)
#pragma unroll
            for (int m = 0; m < 4; ++m)
#pragma unroll
                for (int n = 0; n < 2; ++n) acc[a][b][m][n] = (f32x4){0.f, 0.f, 0.f, 0.f};
    bf16x8 At[4][2], B0[2][2], B1[2][2];
    const char* cA = (const char*)g.A + a_row0(g.amode, cur.pm) * (long)lda * 2; const char* cB = (const char*)g.Bt + (size_t)cur.pn * tstepB;
    PG8_STAGE(PG8_SB(0, 0), cB, voffB); PG8_STAGE(PG8_SB(0, 1), cB + hstepB, voffB); PG8_STAGE(PG8_SA(0, 0), cA, voffA); PG8_STAGE(PG8_SA(0, 1), cA + hstepA, voffA);
    if (wr == 1) PG8_BAR;
    PG8_WAIT_V(2); PG8_BAR;
    PG8_STAGE(PG8_SB(1, 0), cB + kstep, voffB); PG8_STAGE(PG8_SA(1, 0), cA + kstep, voffA); PG8_STAGE(PG8_SB(1, 1), cB + hstepB + kstep, voffB);
    PG8_WAIT_V(6); PG8_BAR;
    for (;;) {
        const bool has_next = S.next(ui + 1, nxt);
        const char* nA = has_next ? (const char*)g.A + a_row0(g.amode, nxt.pm) * (long)lda * 2 : cA; const char* nB = has_next ? (const char*)g.Bt + (size_t)nxt.pn * tstepB : cB;
#pragma unroll 1
        for (int t = 0; t < nt; t += 2) {
            const bool last = (t == nt - 2);
            const char* a1 = cA + (size_t)(t + 1) * kstep;
            const char* a2 = last ? nA : cA + (size_t)(t + 2) * kstep; const char* b2 = last ? nB : cB + (size_t)(t + 2) * kstep;
            const char* a3 = a2 + kstep; const char* b3 = b2 + kstep;
            PG8_LDB(B0, 0, 0); PG8_LDB(B1, 0, 1); PG8_SCHED; PG8_LDA(At, 0, 0); PG8_STAGE(PG8_SA(1, 1), a1 + hstepA, voffA);
            PG8_WAIT_V(8); PG8_WAIT_L(0); PG8_BAR; PG8_MMA(0, 0, At, B0); PG8_MMA(0, 1, At, B1); PG8_BAR; PG8_SCHED;
            PG8_LDA(At, 0, 1); PG8_STAGE(PG8_SB(0, 0), b2, voffB); PG8_STAGE(PG8_SB(0, 1), b2 + hstepB, voffB); PG8_STAGE(PG8_SA(0, 0), a2, voffA);
            PG8_WAIT_V(8); PG8_WAIT_L(0); PG8_BAR; PG8_MMA(1, 0, At, B0); PG8_MMA(1, 1, At, B1); PG8_BAR; PG8_SCHED;
            PG8_LDB(B0, 1, 0); PG8_LDB(B1, 1, 1); PG8_SCHED; PG8_LDA(At, 1, 0); PG8_STAGE(PG8_SA(0, 1), a2 + hstepA, voffA);
            PG8_WAIT_V(8); PG8_WAIT_L(0); PG8_BAR; PG8_MMA(0, 0, At, B0); PG8_MMA(0, 1, At, B1); PG8_BAR; PG8_SCHED;
            PG8_LDA(At, 1, 1); PG8_STAGE(PG8_SB(1, 0), b3, voffB); PG8_STAGE(PG8_SB(1, 1), b3 + hstepB, voffB); PG8_STAGE(PG8_SA(1, 0), a3, voffA);
            PG8_WAIT_V(8); PG8_WAIT_L(0); PG8_BAR; PG8_MMA(1, 0, At, B0); PG8_MMA(1, 1, At, B1); PG8_BAR; PG8_SCHED;
        }
        if (wr == 0) PG8_BAR;
        E(acc, cur, wr, wc, fr, fq);
        if (!has_next) break;
#pragma unroll
        for (int a = 0; a < 2; ++a)
#pragma unroll
            for (int b = 0; b < 2; ++b)
#pragma unroll
                for (int m = 0; m < 4; ++m)
#pragma unroll
                    for (int n = 0; n < 2; ++n) acc[a][b][m][n] = (f32x4){0.f, 0.f, 0.f, 0.f};
        cur = nxt; cA = nA; cB = nB; ++ui;
        if (wr == 1) PG8_BAR;
    }
    PG8_WAIT_V(0);
    PG8_BAR;
#undef PG8_SA
#undef PG8_SB
#undef PG8_STAGE
#undef PG8_LDA
#undef PG8_LDB
#undef PG8_MMA
#undef PG8_WAIT_V
#undef PG8_WAIT_L
#undef PG8_SCHED
}

struct EpiZ {
    bf16_t* Z; float* alr; float* out;
    __device__ __forceinline__ void operator()(const f32x4 (&acc)[2][2][4][2], const Unit& u, int wr, int wc, int fr, int fq) const {
        asm volatile("" : "+v"(fr), "+v"(fq));
        const int row0 = u.pm * BM + wr * 64 + fr;
        if (u.pn == 26) {
            if (wc == 0 && fq < 2) {
#pragma unroll
                for (int ai = 0; ai < 2; ++ai)
#pragma unroll
                    for (int m = 0; m < 4; ++m)
#pragma unroll
                        for (int n = 0; n < 2; ++n) *(f32x4*)(alr + (size_t)(row0 + ai * HALF + m * 16) * 16 + 8 * fq + 4 * n) = acc[ai][0][m][n];
            }
            return;
        }
        const int colt = u.pn * BM;
        float sc = 1.f; if (colt < 512) sc = 0.08838834764831845f; else if (colt >= ZQB && colt < ZKB) sc = 0.125f * LOG2E;
        float* fo = nullptr; long frow0 = 0;
        if (colt >= ZKB && colt < ZGA) {
            const bool isv = colt >= ZVB; const int cc = colt - (isv ? ZVB : ZKB);
            if (u.pm == 256) { fo = out + (isv ? O_VS : O_KS) + cc; frow0 = 0; }
            else if ((u.pm & 31) >= 30) { fo = out + (isv ? O_VP : O_KP) + cc; frow0 = (long)(u.pm >> 5) * 512 + ((u.pm & 31) - 30) * 256; }
        }
        const int colw = wc * 32 + 8 * fq;
#pragma unroll
        for (int ai = 0; ai < 2; ++ai)
#pragma unroll
            for (int m = 0; m < 4; ++m) {
                const int rt = ai * HALF + wr * 64 + m * 16 + fr;
                bf16_t* rowp = Z + (size_t)(u.pm * BM + rt) * ZP + colt + colw;
#pragma unroll
                for (int bj = 0; bj < 2; ++bj) {
                    const f32x4 v0 = acc[ai][bj][m][0] * sc, v1 = acc[ai][bj][m][1] * sc;
                    u32x4 w; w.x = pk2(v0[0], v0[1]); w.y = pk2(v0[2], v0[3]); w.z = pk2(v1[0], v1[1]); w.w = pk2(v1[2], v1[3]);
                    *(u32x4*)(rowp + bj * HALF) = w;
                    if (fo) { float* fp = fo + (size_t)(frow0 + rt) * 512 + colw + bj * HALF; *(f32x4*)fp = v0; *(f32x4*)(fp + 4) = v1; }
                }
                asm volatile("" ::: "memory");
            }
    }
};

template <int MODE> struct EpiEw {
    bf16_t* O; int ldo; const bf16_t* X1; int ld1; const bf16_t* X2; int ld2; float* ssq;
    __device__ __forceinline__ void operator()(const f32x4 (&acc)[2][2][4][2], const Unit& u, int wr, int wc, int fr, int fq) const {
        asm volatile("" : "+v"(fr), "+v"(fq));
        const int col0 = u.pn * BM + wc * 32 + 8 * fq;
#pragma unroll
        for (int ai = 0; ai < 2; ++ai)
#pragma unroll
            for (int m = 0; m < 4; ++m) {
                const size_t row = (size_t)u.pm * BM + ai * HALF + wr * 64 + m * 16 + fr;
                float ss = 0.f;
#pragma unroll
                for (int bj = 0; bj < 2; ++bj) {
                    const int col = col0 + bj * HALF;
                    float v[8];
#pragma unroll
                    for (int e = 0; e < 4; ++e) { v[e] = acc[ai][bj][m][0][e]; v[4 + e] = acc[ai][bj][m][1][e]; }
                    if (MODE == 1 || MODE == 2 || MODE == 4) {
                        const u32x4 a = *(const u32x4*)(X1 + row * ld1 + col);
                        float x[8] = {lo2f(a.x), hi2f(a.x), lo2f(a.y), hi2f(a.y), lo2f(a.z), hi2f(a.z), lo2f(a.w), hi2f(a.w)};
                        if (MODE == 4) {
#pragma unroll
                            for (int e = 0; e < 8; ++e) v[e] = fsigmoid(v[e]) * x[e];
                        } else {
#pragma unroll
                            for (int e = 0; e < 8; ++e) v[e] = fsigmoid(x[e]) * v[e];
                        }
                    }
                    if (MODE == 2) {
                        const u32x4 a = *(const u32x4*)(X2 + row * ld2 + col);
                        float x[8] = {lo2f(a.x), hi2f(a.x), lo2f(a.y), hi2f(a.y), lo2f(a.z), hi2f(a.z), lo2f(a.w), hi2f(a.w)};
#pragma unroll
                        for (int e = 0; e < 8; ++e) v[e] += x[e];
                    }
                    u32x4 w; w.x = pk2(v[0], v[1]); w.y = pk2(v[2], v[3]); w.z = pk2(v[4], v[5]); w.w = pk2(v[6], v[7]);
                    *(u32x4*)(O + row * ldo + col) = w;
                    if (MODE == 3 || MODE == 4) {
#pragma unroll
                        for (int e = 0; e < 8; ++e) ss += v[e] * v[e];
                    }
                }
                if (MODE == 3 || MODE == 4) {
                    ss += __shfl_xor(ss, 16); ss += __shfl_xor(ss, 32);
                    if (fq == 0) ssq[row * 16 + u.pn * 4 + wc] = ss;
                }
                asm volatile("" ::: "memory");
            }
    }
};

__device__ __forceinline__ float dpp_ror1(float v) { return __builtin_bit_cast(float, __builtin_amdgcn_update_dpp(0, __builtin_bit_cast(int, v), 0x121, 0xf, 0xf, false)); }
__device__ __forceinline__ float dpp_ror2(float v) { return __builtin_bit_cast(float, __builtin_amdgcn_update_dpp(0, __builtin_bit_cast(int, v), 0x122, 0xf, 0xf, false)); }
struct EpiConv {
    bf16_t* ACT; const float* convw; const float* convb; const float* state_conv; float* out; LAS float* xb;
    __device__ __forceinline__ void operator()(f32x4 (&acc)[2][2][4][2], const Unit& u, int wr, int wc, int fr, int fq) const {
        asm volatile("" : "+v"(fr), "+v"(fq));
        const bool samp = (u.pm >= 264);
        const int bq = samp ? 0 : u.pm / 33, j = samp ? 0 : u.pm - bq * 33;
        const int trow0 = 254 * j - 2;
        const int c0 = wc * 32 + 8 * fq, ch0 = u.pn * 128 + c0;
        if (!samp && j == 0 && wr == 0 && fr < 2) { acc[0][1][0][0] = (f32x4){0.f, 0.f, 0.f, 0.f}; acc[0][1][0][1] = (f32x4){0.f, 0.f, 0.f, 0.f}; }
        if (fr >= 14) {
#pragma unroll
            for (int ai = 0; ai < 2; ++ai)
#pragma unroll
                for (int n = 0; n < 2; ++n) *(LAS f32x4*)(xb + ((2 * ai + wr) * 2 + (fr - 14)) * 128 + c0 + 4 * n) = acc[ai][1][3][n];
        }
        asm volatile("s_waitcnt lgkmcnt(0)" ::: "memory"); __builtin_amdgcn_s_barrier(); asm volatile("" ::: "memory");
#pragma unroll
        for (int n = 0; n < 2; ++n) {
            const f32x4 w0 = *(const f32x4*)(convw + ch0 + 4 * n), w1 = *(const f32x4*)(convw + DFF + ch0 + 4 * n), w2 = *(const f32x4*)(convw + 2 * DFF + ch0 + 4 * n), cb = *(const f32x4*)(convb + ch0 + 4 * n);
#pragma unroll
            for (int ai = 0; ai < 2; ++ai)
#pragma unroll
                for (int m = 0; m < 4; ++m) {
                    const int r = ai * HALF + wr * 64 + m * 16 + fr;
                    f32x4 pv;
                    if (samp && (m & 1) == 0) pv = *(const f32x4*)(state_conv + (size_t)((r >> 5) * 2 + (fr & 1)) * DFF + ch0 + 4 * n);
                    else if (m == 0) { const int blk = 2 * ai + wr; pv = blk > 0 ? *(const LAS f32x4*)(xb + ((blk - 1) * 2 + (fr & 1)) * 128 + c0 + 4 * n) : (f32x4){0.f, 0.f, 0.f, 0.f}; }
                    else pv = acc[ai][1][m - 1][n];
                    float y[4];
#pragma unroll
                    for (int e = 0; e < 4; ++e) {
                        const float G = acc[ai][1][m][n][e];
                        const float x1 = dpp_ror1(G), x2 = dpp_ror2(G), p1 = dpp_ror1(pv[e]), p2 = dpp_ror2(pv[e]);
                        const float gm1 = fr >= 1 ? x1 : p1, gm2 = fr >= 2 ? x2 : p2;
                        const float gc = cb[e] + w0[e] * gm2 + w1[e] * gm1 + w2[e] * G;
                        const float uu = 0.7978845608028654f * (gc + 0.044715f * gc * gc * gc);
                        const float ge = gc * __builtin_amdgcn_rcpf(1.0f + __builtin_amdgcn_exp2f(-2.0f * LOG2E * uu));
                        y[e] = ge * acc[ai][0][m][n][e];
                    }
                    u32x2 w; w.x = pk2(y[0], y[1]); w.y = pk2(y[2], y[3]);
                    if (samp) {
                        *(u32x2*)(ACT + (size_t)(TP + r) * DFF + ch0 + 4 * n) = w;
                        const int t = r & 31;
                        if (t >= 30) *(f32x4*)(out + O_CS + (size_t)((r >> 5) * 2 + (t - 30)) * DFF + ch0 + 4 * n) = acc[ai][1][m][n];
                    } else {
                        const int t = trow0 + r;
                        if (r >= 2 && t < SEQ) {
                            *(u32x2*)(ACT + (size_t)(bq * SEQ + t) * DFF + ch0 + 4 * n) = w;
                            if (t >= SEQ - 2) *(f32x4*)(out + O_CP + (size_t)(bq * 2 + (t - (SEQ - 2))) * DFF + ch0 + 4 * n) = acc[ai][1][m][n];
                        }
                    }
                    asm volatile("" ::: "memory");
                }
        }
        asm volatile("s_waitcnt lgkmcnt(0)" ::: "memory"); __builtin_amdgcn_s_barrier(); asm volatile("" ::: "memory");
    }
};
#undef PG8_BAR
}

constexpr int NWAVES = 8, NTHR = 512;
constexpr int RING_BYTES = 131072, XB_OFF = RING_BYTES, LDS_BYTES = 147456;

struct Args {
    const float* in[28]; float* out; unsigned char* ws; int ph_lo, ph_hi;
};
struct Frame {
    LAS unsigned char* lds; int tid, lane, wave, vcu, G;
};
__device__ __forceinline__ void fresh(Frame& F) { int t = threadIdx.x; asm volatile("" : "+v"(t)); F.tid = t; F.lane = t & 63; F.wave = __builtin_amdgcn_readfirstlane(t >> 6); }

__device__ __forceinline__ void transpose_item(const float* W, int ldw, int K, bf16_t* WT, int k0, int c_src, int r_dst, int nvalid, LAS float* scr, int lane) {
#pragma unroll 8
    for (int i = 0; i < 32; ++i) { const int kk = 2 * i + (lane >> 5); const int c = lane & 31; scr[kk * 33 + c] = (c < nvalid) ? W[(size_t)(k0 + kk) * ldw + c_src + c] : 0.f; }
    LDS_WAIT(); asm volatile("" ::: "memory");
    const int c = lane & 7;
#pragma unroll
    for (int jj = 0; jj < 4; ++jj) { const int n = (lane >> 3) + 8 * jj; const LAS float* s = scr + (8 * c) * 33 + n;
        u32x4 o; o.x = pk2(s[0 * 33], s[1 * 33]); o.y = pk2(s[2 * 33], s[3 * 33]); o.z = pk2(s[4 * 33], s[5 * 33]); o.w = pk2(s[6 * 33], s[7 * 33]);
        *(u32x4*)(WT + (size_t)(r_dst + n) * K + k0 + 8 * c) = o; }
    LDS_WAIT(); asm volatile("" ::: "memory");
}

__device__ __forceinline__ const float* xrow_ptr(const Args& a, int m) { return m < TP ? a.in[0] + (size_t)m * DM : a.in[1] + (size_t)(m - TP) * DM; }

__device__ __forceinline__ void p0_prologue(const Args& a, Frame& F) {
    LAS float* scr = (LAS float*)(F.lds + F.wave * 16384);
    const int gw = F.vcu * NWAVES + F.wave, NGW = F.G * NWAVES;
    unsigned char* ws = a.ws;
    constexpr int I_IN = 16 * 216, I_BRA = 16 * 32, I_BRB = 8 * 32, I_OUT = 16 * 32, I_UP = 16 * 176, I_DN = 44 * 32, I_PG = 16 * 32, I_PLE = 4 * 32;
    constexpr int NITEMS = I_IN + I_BRA + I_BRB + I_OUT + I_UP + I_DN + I_PG + I_PLE;
    for (int it = gw; it < NITEMS; it += NGW) {
        int r = it;
        if (r < I_IN) { const int kb = r / 216, nb = r % 216; const int dst = nb * 32;
            int src, nv = 32; if (dst < 3072) src = dst; else if (dst < 6656) src = dst + 16; else if (dst == 6656) { src = 3072; nv = 16; } else { src = 0; nv = 0; }
            transpose_item(a.in[9], 6672, 1024, (bf16_t*)(ws + WS_WIN), kb * 64, src, dst, nv, scr, F.lane); continue; } r -= I_IN;
        if (r < I_BRA) { transpose_item(a.in[14], 1024, 1024, (bf16_t*)(ws + WS_WBRA), (r / 32) * 64, (r % 32) * 32, (r % 32) * 32, 32, scr, F.lane); continue; } r -= I_BRA;
        if (r < I_BRB) { transpose_item(a.in[15], 1024, 512, (bf16_t*)(ws + WS_WBRB), (r / 32) * 64, (r % 32) * 32, (r % 32) * 32, 32, scr, F.lane); continue; } r -= I_BRB;
        if (r < I_OUT) { transpose_item(a.in[16], 1024, 1024, (bf16_t*)(ws + WS_WOUT), (r / 32) * 64, (r % 32) * 32, (r % 32) * 32, 32, scr, F.lane); continue; } r -= I_OUT;
        if (r < I_UP) { const int kb = r / 176, nb = r % 176; const int tile = nb >> 3, sub = nb & 7;
            const int src = sub < 4 ? 128 * tile + 32 * sub : DFF + 128 * tile + 32 * (sub - 4);
            transpose_item(a.in[19], 2 * DFF, 1024, (bf16_t*)(ws + WS_WUP), kb * 64, src, nb * 32, 32, scr, F.lane); continue; } r -= I_UP;
        if (r < I_DN) { transpose_item(a.in[22], 1024, DFF, (bf16_t*)(ws + WS_WDN), (r / 32) * 64, (r % 32) * 32, (r % 32) * 32, 32, scr, F.lane); continue; } r -= I_DN;
        if (r < I_PG) { transpose_item(a.in[25], 1024, 1024, (bf16_t*)(ws + WS_WPG), (r / 32) * 64, (r % 32) * 32, (r % 32) * 32, 32, scr, F.lane); continue; } r -= I_PG;
        transpose_item(a.in[26], 1024, 256, (bf16_t*)(ws + WS_WPLE), (r / 32) * 64, (r % 32) * 32, (r % 32) * 32, 32, scr, F.lane);
    }
    bf16_t* H0 = (bf16_t*)((unsigned char*)a.out + YO_B1);
    const float* gp = a.in[8];
    f32x4 gv[4];
#pragma unroll
    for (int j = 0; j < 4; ++j) gv[j] = *((const f32x4*)gp + F.lane + 64 * j);
    for (int m = gw; m < TT; m += NGW) {
        const f32x4* xr = (const f32x4*)xrow_ptr(a, m) + F.lane;
        f32x4 v[4]; float s = 0.f;
#pragma unroll
        for (int j = 0; j < 4; ++j) { v[j] = xr[64 * j]; s += (v[j].x * v[j].x + v[j].y * v[j].y) + (v[j].z * v[j].z + v[j].w * v[j].w); }
        const float rstd = 1.0f / sqrtf(wave_sum(s) * (1.f / DM) + EPS);
        u32x2* o8 = (u32x2*)(H0 + (size_t)m * DM) + F.lane;
#pragma unroll
        for (int j = 0; j < 4; ++j) { u32x2 w; w.x = pk2(v[j].x * rstd * gv[j].x, v[j].y * rstd * gv[j].y); w.y = pk2(v[j].z * rstd * gv[j].z, v[j].w * rstd * gv[j].w); o8[64 * j] = w; }
    }
}

template <bool HAS_H, bool HAS_PB>
__device__ __forceinline__ void row_pass(const Args& a, Frame& F, bool x_from_input, const bf16_t* BR, const float* ssq, const float* gpost, const float* gpre, bf16_t* HO, bf16_t* PB) {
    const int gw = F.vcu * NWAVES + F.wave, NGW = F.G * NWAVES;
    float* X = a.out;
    f32x4 g1[4], g2[4];
#pragma unroll
    for (int j = 0; j < 4; ++j) { g1[j] = *((const f32x4*)gpost + F.lane + 64 * j); if (HAS_H) g2[j] = *((const f32x4*)gpre + F.lane + 64 * j); }
    for (int m = gw; m < TT; m += NGW) {
        const f32x4* xr = (const f32x4*)(x_from_input ? xrow_ptr(a, m) : X + (size_t)m * DM) + F.lane;
        const u32x2* br = (const u32x2*)(BR + (size_t)m * DM) + F.lane;
        const f32x4 sq0 = *(const f32x4*)(ssq + (size_t)m * 16), sq1 = *(const f32x4*)(ssq + (size_t)m * 16 + 4), sq2 = *(const f32x4*)(ssq + (size_t)m * 16 + 8), sq3 = *(const f32x4*)(ssq + (size_t)m * 16 + 12);
        const float tot = ((sq0.x + sq0.y) + (sq0.z + sq0.w)) + ((sq1.x + sq1.y) + (sq1.z + sq1.w)) + ((sq2.x + sq2.y) + (sq2.z + sq2.w)) + ((sq3.x + sq3.y) + (sq3.z + sq3.w));
        const float rs = 1.0f / sqrtf(tot * (1.f / DM) + EPS);
        f32x4 v[4]; float s = 0.f;
#pragma unroll
        for (int j = 0; j < 4; ++j) { const f32x4 x = xr[64 * j]; const u32x2 b = br[64 * j];
            v[j].x = x.x + lo2f(b.x) * rs * g1[j].x; v[j].y = x.y + hi2f(b.x) * rs * g1[j].y; v[j].z = x.z + lo2f(b.y) * rs * g1[j].z; v[j].w = x.w + hi2f(b.y) * rs * g1[j].w;
            s += (v[j].x * v[j].x + v[j].y * v[j].y) + (v[j].z * v[j].z + v[j].w * v[j].w); }
        f32x4* xo = (f32x4*)(X + (size_t)m * DM) + F.lane;
#pragma unroll
        for (int j = 0; j < 4; ++j) xo[64 * j] = v[j];
        if (HAS_H) {
            const float rstd = 1.0f / sqrtf(wave_sum(s) * (1.f / DM) + EPS);
            u32x2* o8 = (u32x2*)(HO + (size_t)m * DM) + F.lane;
#pragma unroll
            for (int j = 0; j < 4; ++j) { u32x2 w; w.x = pk2(v[j].x * rstd * g2[j].x, v[j].y * rstd * g2[j].y); w.y = pk2(v[j].z * rstd * g2[j].z, v[j].w * rstd * g2[j].w); o8[64 * j] = w; }
        }
        if (HAS_PB) {
            const float* pe = m < TP ? a.in[6] + (size_t)m * 256 : a.in[7] + (size_t)(m - TP) * 256;
            const f32x4 p = *((const f32x4*)pe + F.lane);
            u32x2 w; w.x = pk2(p.x, p.y); w.y = pk2(p.z, p.w);
            *((u32x2*)(PB + (size_t)m * 256) + F.lane) = w;
        }
    }
}

__device__ __forceinline__ float log_sigmoid(float x) {
    const float e = __builtin_amdgcn_exp2f(-fabsf(x) * LOG2E);
    return fminf(x, 0.f) - __builtin_amdgcn_logf(1.0f + e) * 0.6931471805599453f;
}

__device__ __forceinline__ void gla_prepass_item(const Args& a, Frame& F, int item) {
    const int n = item & 127, h = (item >> 7) & 3, b = item >> 9;
    const size_t row0 = (size_t)b * SEQ + 64 * n;
    bf16_t* Z = (bf16_t*)(a.ws + WS_Z);
    const float* alr = (const float*)((unsigned char*)a.out + YO_ALR);
    bf16_t* PS = (bf16_t*)((unsigned char*)a.out + YO_PS) + (size_t)item * 4096;
    float* DL = (float*)((unsigned char*)a.out + YO_DL) + (size_t)item * 128;
    LAS float* AL = (LAS float*)(F.lds);
    LAS float* WA = (LAS float*)(F.lds + 4096);
    LAS float* BA = (LAS float*)(F.lds + 12288);
    LAS float* GS = (LAS float*)(F.lds + 12800);
    LAS bf16_t* QL = (LAS bf16_t*)(F.lds + 16384);
    LAS bf16_t* KL = (LAS bf16_t*)(F.lds + 16384 + 17408);
    LAS bf16_t* VL = (LAS bf16_t*)(F.lds + 16384 + 2 * 17408);
    const int tid = F.tid;
    if (tid < 256) *(LAS f32x4*)(AL + tid * 4) = *(const f32x4*)(alr + row0 * 16 + tid * 4);
    { const int r = tid >> 5, c4 = (tid & 31) * 4; *(LAS f32x4*)(WA + r * 128 + c4) = *(const f32x4*)(a.in[10] + (size_t)r * 512 + h * 128 + c4); }
    if (tid < 128) BA[tid] = a.in[11][h * 128 + tid];
#pragma unroll
    for (int i = 0; i < 4; ++i) { const int c = tid + 512 * i; const int t = c >> 5, d8 = (c & 31) * 8;
        *(LAS u32x4*)(VL + t * 264 + d8) = *(const u32x4*)(Z + (row0 + t) * ZP + ZVA + h * 256 + d8); }
    BLOCK_SYNC();
    const int c = tid & 127, tg = tid >> 7;
    float cs[16];
    {
        float wv[16];
#pragma unroll
        for (int r = 0; r < 16; ++r) wv[r] = WA[r * 128 + c];
        const float bb = BA[c];
        float run = 0.f;
#pragma unroll
        for (int i = 0; i < 16; ++i) {
            const int t = tg * 16 + i; float d = bb;
#pragma unroll
            for (int r4 = 0; r4 < 4; ++r4) { const f32x4 av = *(const LAS f32x4*)(AL + t * 16 + r4 * 4); d += av.x * wv[r4 * 4] + av.y * wv[r4 * 4 + 1] + av.z * wv[r4 * 4 + 2] + av.w * wv[r4 * 4 + 3]; }
            run += log_sigmoid(d) * (1.0f / 16.0f); cs[i] = run;
        }
        GS[tg * 128 + c] = run;
    }
    BLOCK_SYNC();
    {
        float off = 0.f;
#pragma unroll
        for (int g2 = 0; g2 < 3; ++g2) if (g2 < tg) off += GS[g2 * 128 + c];
#pragma unroll
        for (int i = 0; i < 16; ++i) {
            const int t = tg * 16 + i; const float bcum = cs[i] + off;
            const float eb = __builtin_amdgcn_exp2f(bcum * LOG2E), enb = __builtin_amdgcn_exp2f(-bcum * LOG2E);
            const float q = bf2f(Z[(row0 + t) * ZP + ZQA + h * 128 + c]), k = bf2f(Z[(row0 + t) * ZP + ZKA + h * 128 + c]);
            QL[t * 136 + c] = (bf16_t)(pk2(q * eb, 0.f) & 0xffffu); KL[t * 136 + c] = (bf16_t)(pk2(k * enb, 0.f) & 0xffffu);
            if (t == 63) DL[c] = eb;
        }
    }
    BLOCK_SYNC();
    {
        const int lr = F.lane & 15, g = F.lane >> 4, mt = F.wave >> 1;
#pragma unroll
        for (int jj = 0; jj < 2; ++jj) {
            const int jt = 2 * (F.wave & 1) + jj;
            f32x4 s = {0.f, 0.f, 0.f, 0.f};
#pragma unroll
            for (int ks = 0; ks < 4; ++ks) {
                const bf16x8 kf = *(const LAS bf16x8*)(KL + (16 * jt + lr) * 136 + 32 * ks + 8 * g);
                const bf16x8 qf = *(const LAS bf16x8*)(QL + (16 * mt + lr) * 136 + 32 * ks + 8 * g);
                s = __builtin_amdgcn_mfma_f32_16x16x32_bf16(kf, qf, s, 0, 0, 0);
            }
            const int i = 16 * mt + lr, j0 = 16 * jt + 4 * g;
            float v0 = (j0 + 0 <= i) ? s[0] : 0.f, v1 = (j0 + 1 <= i) ? s[1] : 0.f, v2 = (j0 + 2 <= i) ? s[2] : 0.f, v3 = (j0 + 3 <= i) ? s[3] : 0.f;
            u32x2 w; w.x = pk2(v0, v1); w.y = pk2(v2, v3);
            *(u32x2*)(PS + i * 64 + j0) = w;
        }
    }
#pragma unroll
    for (int i = 0; i < 2; ++i) { const int cc = tid + 512 * i; const int t = cc >> 4, p8 = cc & 15, s = p8 >> 2, g = p8 & 3;
        const u32x2 lo = *(const LAS u32x2*)(QL + t * 136 + 32 * s + 4 * g), hi = *(const LAS u32x2*)(QL + t * 136 + 32 * s + 16 + 4 * g);
        u32x4 w; w.x = lo.x; w.y = lo.y; w.z = hi.x; w.w = hi.y;
        *(u32x4*)(Z + (row0 + t) * ZP + ZQA + h * 128 + 8 * p8) = w; }
#pragma unroll
    for (int i = 0; i < 2; ++i) { const int cc = tid + 512 * i; const int ch = cc >> 3, t8 = cc & 7;
        unsigned e[8];
#pragma unroll
        for (int q = 0; q < 8; ++q) e[q] = KL[(8 * t8 + q) * 136 + ch];
        u32x4 w; w.x = e[0] | (e[1] << 16); w.y = e[2] | (e[3] << 16); w.z = e[4] | (e[5] << 16); w.w = e[6] | (e[7] << 16);
        *(u32x4*)(Z + (row0 + (ch >> 1)) * ZP + ZKA + h * 128 + (ch & 1) * 64 + 8 * t8) = w; }
#pragma unroll
    for (int i = 0; i < 4; ++i) { const int cc = tid + 512 * i; const int dv = cc >> 3, t8 = cc & 7;
        unsigned e[8];
#pragma unroll
        for (int q = 0; q < 8; ++q) e[q] = VL[(8 * t8 + q) * 264 + dv];
        u32x4 w; w.x = e[0] | (e[1] << 16); w.y = e[2] | (e[3] << 16); w.z = e[4] | (e[5] << 16); w.w = e[6] | (e[7] << 16);
        *(u32x4*)(Z + (row0 + (dv >> 2)) * ZP + ZVA + h * 256 + (dv & 3) * 64 + 8 * t8) = w; }
    BLOCK_SYNC();
}

__device__ __forceinline__ void gla_chain(const Args& a, Frame& F, int b, int h) {
    bf16_t* Z = (bf16_t*)(a.ws + WS_Z);
    const bf16_t* PSg = (const bf16_t*)((unsigned char*)a.out + YO_PS);
    const float* DLg = (const float*)((unsigned char*)a.out + YO_DL);
    constexpr int BUFB = 45056;
    LAS float* XS = (LAS float*)(F.lds + 2 * BUFB);
    LAS float* DLs = (LAS float*)(F.lds + 2 * BUFB + 4096);
    const int tid = F.tid, lane = F.lane, w = F.wave, lr = lane & 15, g = lane >> 4;
    const float* ggla = a.in[12] + h * 256;
    float gg[2]; gg[0] = ggla[32 * w + lr]; gg[1] = ggla[32 * w + 16 + lr];
    f32x4 S[8][2];
#pragma unroll
    for (int mt = 0; mt < 8; ++mt) { S[mt][0] = (f32x4){0.f, 0.f, 0.f, 0.f}; S[mt][1] = (f32x4){0.f, 0.f, 0.f, 0.f}; }
    u32x4 sq[2], sk[2], sp; f32x4 sd = {0.f, 0.f, 0.f, 0.f}; bf16x8 Vn[2][2], Vf[2][2];
#define GC_LOAD(nn) do { const size_t r0_ = (size_t)b * SEQ + 64 * (nn); const int item_ = (b * 4 + h) * 128 + (nn); \
        _Pragma("unroll") for (int i_ = 0; i_ < 2; ++i_) { const int c_ = tid + 512 * i_; \
            sq[i_] = *(const u32x4*)(Z + (r0_ + (c_ >> 4)) * ZP + ZQA + h * 128 + 8 * (c_ & 15)); \
            const int ch_ = c_ >> 3; sk[i_] = *(const u32x4*)(Z + (r0_ + (ch_ >> 1)) * ZP + ZKA + h * 128 + (ch_ & 1) * 64 + 8 * (c_ & 7)); } \
        sp = *(const u32x4*)(PSg + (size_t)item_ * 4096 + (tid >> 3) * 64 + 8 * (tid & 7)); \
        if (tid < 32) sd = *(const f32x4*)(DLg + (size_t)item_ * 128 + 4 * tid); \
        _Pragma("unroll") for (int nt_ = 0; nt_ < 2; ++nt_) _Pragma("unroll") for (int ks_ = 0; ks_ < 2; ++ks_) { const int dv_ = 32 * w + 16 * nt_ + lr; \
            Vn[nt_][ks_] = *(const bf16x8*)(Z + (r0_ + (dv_ >> 2)) * ZP + ZVA + h * 256 + (dv_ & 3) * 64 + 32 * ks_ + 8 * g); } } while (0)
#define GC_STORE(bufi) do { LAS unsigned char* B_ = F.lds + (bufi) * BUFB; \
        _Pragma("unroll") for (int i_ = 0; i_ < 2; ++i_) { const int c_ = tid + 512 * i_; \
            *(LAS u32x4*)(B_ + ((c_ >> 4) * 136 + 8 * (c_ & 15)) * 2) = sq[i_]; \
            *(LAS u32x4*)(B_ + 17408 + ((c_ >> 3) * 72 + 8 * (c_ & 7)) * 2) = sk[i_]; } \
        *(LAS u32x4*)(B_ + 17408 + 18432 + ((tid >> 3) * 72 + 8 * (tid & 7)) * 2) = sp; \
        if (tid < 32) *(LAS f32x4*)(DLs + (bufi) * 128 + 4 * tid) = sd; } while (0)
    GC_LOAD(0); GC_STORE(0);
#pragma unroll
    for (int nt = 0; nt < 2; ++nt) { Vf[nt][0] = Vn[nt][0]; Vf[nt][1] = Vn[nt][1]; }
    BLOCK_SYNC();
    for (int n = 0; n < 128; ++n) {
        const int bi = n & 1;
        const size_t row0 = (size_t)b * SEQ + 64 * n;
        if (n + 1 < 128) GC_LOAD(n + 1);
        const LAS bf16_t* QL = (const LAS bf16_t*)(F.lds + bi * BUFB);
        const LAS bf16_t* KT = (const LAS bf16_t*)(F.lds + bi * BUFB + 17408);
        const LAS bf16_t* PL = (const LAS bf16_t*)(F.lds + bi * BUFB + 17408 + 18432);
        f32x4 o[4][2];
#pragma unroll
        for (int mt = 0; mt < 4; ++mt) { o[mt][0] = (f32x4){0.f, 0.f, 0.f, 0.f}; o[mt][1] = (f32x4){0.f, 0.f, 0.f, 0.f}; }
#pragma unroll
        for (int ks = 0; ks < 2; ++ks)
#pragma unroll
            for (int mt = 0; mt < 4; ++mt) {
                const bf16x8 pf = *(const LAS bf16x8*)(PL + (16 * mt + lr) * 72 + 32 * ks + 8 * g);
                o[mt][0] = __builtin_amdgcn_mfma_f32_16x16x32_bf16(pf, Vf[0][ks], o[mt][0], 0, 0, 0);
                o[mt][1] = __builtin_amdgcn_mfma_f32_16x16x32_bf16(pf, Vf[1][ks], o[mt][1], 0, 0, 0);
            }
        if (n + 1 < 128) GC_STORE(bi ^ 1);
#pragma unroll
        for (int s = 0; s < 4; ++s) {
            bf16x8 sb[2];
#pragma unroll
            for (int nt = 0; nt < 2; ++nt) { u32x4 t; t.x = pk2(S[2 * s][nt][0], S[2 * s][nt][1]); t.y = pk2(S[2 * s][nt][2], S[2 * s][nt][3]); t.z = pk2(S[2 * s + 1][nt][0], S[2 * s + 1][nt][1]); t.w = pk2(S[2 * s + 1][nt][2], S[2 * s + 1][nt][3]); sb[nt] = __builtin_bit_cast(bf16x8, t); }
#pragma unroll
            for (int mt = 0; mt < 4; ++mt) {
                const bf16x8 qf = *(const LAS bf16x8*)(QL + (16 * mt + lr) * 136 + 32 * s + 8 * g);
                o[mt][0] = __builtin_amdgcn_mfma_f32_16x16x32_bf16(qf, sb[0], o[mt][0], 0, 0, 0);
                o[mt][1] = __builtin_amdgcn_mfma_f32_16x16x32_bf16(qf, sb[1], o[mt][1], 0, 0, 0);
            }
        }
#pragma unroll
        for (int mt = 0; mt < 8; ++mt) {
#pragma unroll
            for (int ks = 0; ks < 2; ++ks) {
                const bf16x8 kf = *(const LAS bf16x8*)(KT + (16 * mt + lr) * 72 + 32 * ks + 8 * g);
                S[mt][0] = __builtin_amdgcn_mfma_f32_16x16x32_bf16(kf, Vf[0][ks], S[mt][0], 0, 0, 0);
                S[mt][1] = __builtin_amdgcn_mfma_f32_16x16x32_bf16(kf, Vf[1][ks], S[mt][1], 0, 0, 0);
            }
            const f32x4 dd = *(const LAS f32x4*)(DLs + bi * 128 + 16 * mt + 4 * g);
            S[mt][0] = S[mt][0] * dd; S[mt][1] = S[mt][1] * dd;
        }
#pragma unroll
        for (int mt = 0; mt < 4; ++mt)
#pragma unroll
            for (int i = 0; i < 4; ++i) {
                float p = o[mt][0][i] * o[mt][0][i] + o[mt][1][i] * o[mt][1][i];
                p += __shfl_xor(p, 1); p += __shfl_xor(p, 2); p += __shfl_xor(p, 4); p += __shfl_xor(p, 8);
                if (lr == 0) XS[(bi * 64 + 16 * mt + 4 * g + i) * 8 + w] = p;
            }
        BLOCK_SYNC();
#pragma unroll
        for (int mt = 0; mt < 4; ++mt)
#pragma unroll
            for (int i = 0; i < 4; ++i) {
                const int tok = 16 * mt + 4 * g + i;
                const f32x4 x0 = *(const LAS f32x4*)(XS + (bi * 64 + tok) * 8), x1 = *(const LAS f32x4*)(XS + (bi * 64 + tok) * 8 + 4);
                const float tot = ((x0.x + x0.y) + (x0.z + x0.w)) + ((x1.x + x1.y) + (x1.z + x1.w));
                const float rstd = 1.0f / sqrtf(tot * (1.0f / 256.0f) + EPS);
#pragma unroll
                for (int nt = 0; nt < 2; ++nt) {
                    bf16_t* rp = Z + (row0 + tok) * ZP + ZRA + h * 256 + 32 * w + 16 * nt + lr;
                    const float r = bf2f(*rp);
                    const float v = o[mt][nt][i] * rstd * gg[nt] * (r * fsigmoid(r));
                    *rp = (bf16_t)(pk2(v, 0.f) & 0xffffu);
                }
            }
#pragma unroll
        for (int nt = 0; nt < 2; ++nt) { Vf[nt][0] = Vn[nt][0]; Vf[nt][1] = Vn[nt][1]; }
    }
#undef GC_LOAD
#undef GC_STORE
    float* so = a.out + O_SP + (size_t)(b * 4 + h) * 128 * 256;
    int lr2 = lr, g2 = g; asm volatile("" : "+v"(lr2), "+v"(g2));
#pragma unroll
    for (int mt = 0; mt < 8; ++mt)
#pragma unroll
        for (int nt = 0; nt < 2; ++nt)
#pragma unroll
            for (int i = 0; i < 4; ++i) so[(size_t)(16 * mt + 4 * g2 + i) * 256 + 32 * w + 16 * nt + lr2] = S[mt][nt][i];
    BLOCK_SYNC();
}

__device__ __forceinline__ void gla_sample_item(const Args& a, Frame& F, int bs, int h) {
    bf16_t* Z = (bf16_t*)(a.ws + WS_Z);
    const float* alr = (const float*)((unsigned char*)a.out + YO_ALR);
    const size_t row0 = (size_t)TP + 32 * bs;
    LAS float* GA = (LAS float*)(F.lds);
    LAS float* KL = (LAS float*)(F.lds + 16384);
    LAS float* QL = (LAS float*)(F.lds + 32768);
    LAS float* OL = (LAS float*)(F.lds + 49152);
    const int tid = F.tid;
    {
        const int c = tid & 127, tg = tid >> 7;
        float wv[16];
#pragma unroll
        for (int r = 0; r < 16; ++r) wv[r] = a.in[10][(size_t)r * 512 + h * 128 + c];
        const float bb = a.in[11][h * 128 + c];
#pragma unroll
        for (int i = 0; i < 8; ++i) {
            const int t = tg * 8 + i; float d = bb;
#pragma unroll
            for (int r = 0; r < 16; ++r) d += alr[(row0 + t) * 16 + r] * wv[r];
            GA[t * 128 + c] = __builtin_amdgcn_exp2f(log_sigmoid(d) * (LOG2E / 16.0f));
            KL[t * 128 + c] = bf2f(Z[(row0 + t) * ZP + ZKA + h * 128 + c]);
            QL[t * 128 + c] = bf2f(Z[(row0 + t) * ZP + ZQA + h * 128 + c]);
        }
    }
    BLOCK_SYNC();
    {
        const int dv = tid & 255, kh = tid >> 8;
        const float* s0 = a.in[4] + ((size_t)(bs * 4 + h) * 128 + kh * 64) * 256 + dv;
        float S[64];
#pragma unroll
        for (int i = 0; i < 64; ++i) S[i] = s0[(size_t)i * 256];
        for (int t = 0; t < 32; ++t) {
            const float v = bf2f(Z[(row0 + t) * ZP + ZVA + h * 256 + dv]);
            float acc = 0.f;
#pragma unroll
            for (int i4 = 0; i4 < 16; ++i4) {
                const f32x4 ga = *(const LAS f32x4*)(GA + t * 128 + kh * 64 + 4 * i4), kk = *(const LAS f32x4*)(KL + t * 128 + kh * 64 + 4 * i4), qq = *(const LAS f32x4*)(QL + t * 128 + kh * 64 + 4 * i4);
#pragma unroll
                for (int e = 0; e < 4; ++e) { S[4 * i4 + e] = ga[e] * S[4 * i4 + e] + kk[e] * v; acc += qq[e] * S[4 * i4 + e]; }
            }
            OL[(t * 2 + kh) * 256 + dv] = acc;
        }
        float* so = a.out + O_SS + ((size_t)(bs * 4 + h) * 128 + kh * 64) * 256 + dv;
#pragma unroll
        for (int i = 0; i < 64; ++i) so[(size_t)i * 256] = S[i];
    }
    BLOCK_SYNC();
    {
        const float* ggla = a.in[12] + h * 256;
        const f32x4 gg = *(const f32x4*)(ggla + 4 * F.lane);
#pragma unroll
        for (int i = 0; i < 4; ++i) {
            const int t = F.wave * 4 + i;
            const f32x4 o0 = *(const LAS f32x4*)(OL + (t * 2) * 256 + 4 * F.lane), o1 = *(const LAS f32x4*)(OL + (t * 2 + 1) * 256 + 4 * F.lane);
            const f32x4 o = o0 + o1;
            const float ss = wave_sum((o.x * o.x + o.y * o.y) + (o.z * o.z + o.w * o.w));
            const float rstd = 1.0f / sqrtf(ss * (1.0f / 256.0f) + EPS);
            u32x2* rp = (u32x2*)(Z + (row0 + t) * ZP + ZRA + h * 256 + 4 * F.lane);
            const u32x2 rr = *rp;
            const float r0 = lo2f(rr.x), r1 = hi2f(rr.x), r2 = lo2f(rr.y), r3 = hi2f(rr.y);
            u32x2 wv; wv.x = pk2(o.x * rstd * gg.x * (r0 * fsigmoid(r0)), o.y * rstd * gg.y * (r1 * fsigmoid(r1)));
            wv.y = pk2(o.z * rstd * gg.z * (r2 * fsigmoid(r2)), o.w * rstd * gg.w * (r3 * fsigmoid(r3)));
            *rp = wv;
        }
    }
    BLOCK_SYNC();
}

__device__ __forceinline__ void attn_unit(const Args& a, Frame& F, int kind, int b, int h, int qg) {
    bf16_t* Z = (bf16_t*)(a.ws + WS_Z);
    LAS bf16_t* KS = (LAS bf16_t*)(F.lds);
    LAS bf16_t* VT = (LAS bf16_t*)(F.lds + 18432);
    LAS float* BI = (LAS float*)(F.lds + 36864);
    const int tid = F.tid, lane = F.lane, w = F.wave, lr = lane & 15, g = lane >> 4;
    const int kt_lo = kind == 0 ? (4 * qg - 8 > 0 ? 4 * qg - 8 : 0) : 0, kt_hi = kind == 0 ? 4 * qg + 3 : 8;
    const bool wact = (kind == 0) || (w == 0);
    const int cq = 4 * qg + (w >> 1);
    const size_t qrow0 = kind == 0 ? (size_t)b * SEQ + 256 * qg + 32 * w : (size_t)TP + 32 * b;
    const int qpos0 = kind == 0 ? 256 * qg + 32 * w : 4096;
    for (int i = tid; i < 257; i += NTHR) BI[i] = a.in[13][h * 257 + i] * LOG2E;
    bf16x8 Qf[2][2];
#pragma unroll
    for (int nt = 0; nt < 2; ++nt)
#pragma unroll
        for (int ks = 0; ks < 2; ++ks) Qf[nt][ks] = wact ? *(const bf16x8*)(Z + (qrow0 + 16 * nt + lr) * ZP + ZQB + h * 64 + 32 * ks + 8 * g) : (bf16x8){0, 0, 0, 0, 0, 0, 0, 0};
    float mrun[2] = {-1e30f, -1e30f}, lrun[2] = {0.f, 0.f};
    f32x4 O[4][2];
#pragma unroll
    for (int md = 0; md < 4; ++md) { O[md][0] = (f32x4){0.f, 0.f, 0.f, 0.f}; O[md][1] = (f32x4){0.f, 0.f, 0.f, 0.f}; }
    const int lj = tid >> 3, ld8 = (tid & 7) * 8;
    u32x4 kreg, vreg;
#define AT_LOAD(kt) do { \
        if (kind == 0) { const size_t r_ = (size_t)b * SEQ + 64 * (kt) + lj; kreg = *(const u32x4*)(Z + r_ * ZP + ZKB + h * 64 + ld8); vreg = *(const u32x4*)(Z + r_ * ZP + ZVB + h * 64 + ld8); } \
        else if ((kt) < 8) { const size_t o_ = ((size_t)(b * 512 + 64 * (kt) + lj) * 8 + h) * 64 + ld8; \
            const f32x4 k0_ = *(const f32x4*)(a.in[2] + o_), k1_ = *(const f32x4*)(a.in[2] + o_ + 4), v0_ = *(const f32x4*)(a.in[3] + o_), v1_ = *(const f32x4*)(a.in[3] + o_ + 4); \
            kreg.x = pk2(k0_.x, k0_.y); kreg.y = pk2(k0_.z, k0_.w); kreg.z = pk2(k1_.x, k1_.y); kreg.w = pk2(k1_.z, k1_.w); \
            vreg.x = pk2(v0_.x, v0_.y); vreg.y = pk2(v0_.z, v0_.w); vreg.z = pk2(v1_.x, v1_.y); vreg.w = pk2(v1_.z, v1_.w); } \
        else if (lj < 32) { const size_t r_ = (size_t)TP + 32 * b + lj; kreg = *(const u32x4*)(Z + r_ * ZP + ZKB + h * 64 + ld8); vreg = *(const u32x4*)(Z + r_ * ZP + ZVB + h * 64 + ld8); } \
        else { kreg = (u32x4){0u, 0u, 0u, 0u}; vreg = (u32x4){0u, 0u, 0u, 0u}; } } while (0)
#define AT_STORE(bufi) do { *(LAS u32x4*)(KS + (bufi) * 4608 + lj * 72 + ld8) = kreg; \
        LAS bf16_t* vt_ = VT + (bufi) * 4608 + ld8 * 72 + lj; \
        vt_[0] = (bf16_t)(vreg.x & 0xffffu); vt_[72] = (bf16_t)(vreg.x >> 16); vt_[144] = (bf16_t)(vreg.y & 0xffffu); vt_[216] = (bf16_t)(vreg.y >> 16); \
        vt_[288] = (bf16_t)(vreg.z & 0xffffu); vt_[360] = (bf16_t)(vreg.z >> 16); vt_[432] = (bf16_t)(vreg.w & 0xffffu); vt_[504] = (bf16_t)(vreg.w >> 16); } while (0)
    AT_LOAD(kt_lo); AT_STORE(0);
    BLOCK_SYNC();
    for (int kt = kt_lo; kt <= kt_hi; ++kt) {
        const int bi = (kt - kt_lo) & 1;
        if (kt < kt_hi) AT_LOAD(kt + 1);
        const bool act = wact && (kind == 1 || (kt >= cq - 8 && kt <= cq));
        if (act) {
            const int kpos0 = kind == 0 ? 64 * kt : (kt < 8 ? 3584 + 64 * kt : 4096);
            const int nvalid = (kind == 1 && kt == 8) ? 32 : 64;
            const LAS bf16_t* Kb = KS + bi * 4608; const LAS bf16_t* Vb = VT + bi * 4608;
            f32x4 St[4][2];
#pragma unroll
            for (int mt = 0; mt < 4; ++mt) { St[mt][0] = (f32x4){0.f, 0.f, 0.f, 0.f}; St[mt][1] = (f32x4){0.f, 0.f, 0.f, 0.f}; }
#pragma unroll
            for (int ks = 0; ks < 2; ++ks)
#pragma unroll
                for (int mt = 0; mt < 4; ++mt) {
                    const bf16x8 kf = *(const LAS bf16x8*)(Kb + (16 * mt + lr) * 72 + 32 * ks + 8 * g);
                    St[mt][0] = __builtin_amdgcn_mfma_f32_16x16x32_bf16(kf, Qf[0][ks], St[mt][0], 0, 0, 0);
                    St[mt][1] = __builtin_amdgcn_mfma_f32_16x16x32_bf16(kf, Qf[1][ks], St[mt][1], 0, 0, 0);
                }
            const int d0 = qpos0 - kpos0;
            if (d0 >= 191) {
                const float cb = BI[256];
#pragma unroll
                for (int mt = 0; mt < 4; ++mt) { St[mt][0] = St[mt][0] + cb; St[mt][1] = St[mt][1] + cb; }
            } else {
#pragma unroll
                for (int mt = 0; mt < 4; ++mt)
#pragma unroll
                    for (int nt = 0; nt < 2; ++nt)
#pragma unroll
                        for (int i = 0; i < 4; ++i) {
                            int dist = d0 + (16 * nt + lr) - (16 * mt + 4 * g + i);
                            dist = dist < -128 ? -128 : (dist > 128 ? 128 : dist);
                            St[mt][nt][i] += BI[dist + 128];
                        }
            }
            if (nvalid < 64) {
#pragma unroll
                for (int mt = 0; mt < 4; ++mt)
#pragma unroll
                    for (int i = 0; i < 4; ++i) if (16 * mt + 4 * g + i >= nvalid) { St[mt][0][i] = -1e30f; St[mt][1][i] = -1e30f; }
            }
#pragma unroll
            for (int nt = 0; nt < 2; ++nt) {
                float tm = -1e30f;
#pragma unroll
                for (int mt = 0; mt < 4; ++mt)
#pragma unroll
                    for (int i = 0; i < 4; ++i) tm = fmaxf(tm, St[mt][nt][i]);
                tm = fmaxf(tm, __shfl_xor(tm, 16)); tm = fmaxf(tm, __shfl_xor(tm, 32));
                const float mnew = fmaxf(mrun[nt], tm);
                const float sc = __builtin_amdgcn_exp2f(mrun[nt] - mnew);
                mrun[nt] = mnew;
                float ps = 0.f;
#pragma unroll
                for (int mt = 0; mt < 4; ++mt)
#pragma unroll
                    for (int i = 0; i < 4; ++i) { const float p = __builtin_amdgcn_exp2f(St[mt][nt][i] - mnew); St[mt][nt][i] = p; ps += p; }
                lrun[nt] = lrun[nt] * sc + ps;
#pragma unroll
                for (int md = 0; md < 4; ++md) O[md][nt] = O[md][nt] * sc;
            }
#pragma unroll
            for (int ks = 0; ks < 2; ++ks) {
                bf16x8 pf[2];
#pragma unroll
                for (int nt = 0; nt < 2; ++nt) { u32x4 t; t.x = pk2(St[2 * ks][nt][0], St[2 * ks][nt][1]); t.y = pk2(St[2 * ks][nt][2], St[2 * ks][nt][3]); t.z = pk2(St[2 * ks + 1][nt][0], St[2 * ks + 1][nt][1]); t.w = pk2(St[2 * ks + 1][nt][2], St[2 * ks + 1][nt][3]); pf[nt] = __builtin_bit_cast(bf16x8, t); }
#pragma unroll
                for (int md = 0; md < 4; ++md) {
                    const u32x2 lo = *(const LAS u32x2*)(Vb + (16 * md + lr) * 72 + 32 * ks + 4 * g), hi = *(const LAS u32x2*)(Vb + (16 * md + lr) * 72 + 32 * ks + 16 + 4 * g);
                    u32x4 t; t.x = lo.x; t.y = lo.y; t.z = hi.x; t.w = hi.y;
                    const bf16x8 vf = __builtin_bit_cast(bf16x8, t);
                    O[md][0] = __builtin_amdgcn_mfma_f32_16x16x32_bf16(vf, pf[0], O[md][0], 0, 0, 0);
                    O[md][1] = __builtin_amdgcn_mfma_f32_16x16x32_bf16(vf, pf[1], O[md][1], 0, 0, 0);
                }
            }
        }
        if (kt < kt_hi) AT_STORE(bi ^ 1);
        BLOCK_SYNC();
    }
#undef AT_LOAD
#undef AT_STORE
    if (wact) {
#pragma unroll
        for (int nt = 0; nt < 2; ++nt) {
            float l = lrun[nt]; l += __shfl_xor(l, 16); l += __shfl_xor(l, 32);
            const float inv = 1.0f / l;
#pragma unroll
            for (int md = 0; md < 4; ++md) {
                u32x2 wv; wv.x = pk2(O[md][nt][0] * inv, O[md][nt][1] * inv); wv.y = pk2(O[md][nt][2] * inv, O[md][nt][3] * inv);
                *(u32x2*)(Z + (qrow0 + 16 * nt + lr) * ZP + ZQB + h * 64 + 16 * md + 4 * g) = wv;
            }
        }
    }
}

__device__ __forceinline__ void grid_bar(unsigned* ctr, unsigned target) {
    asm volatile("s_waitcnt vmcnt(0) lgkmcnt(0)" ::: "memory");
    __syncthreads();
    if (threadIdx.x == 0) {
        __builtin_amdgcn_fence(__ATOMIC_RELEASE, "agent");
        asm volatile("s_waitcnt vmcnt(0)" ::: "memory");
        __hip_atomic_fetch_add(ctr, 1u, __ATOMIC_RELAXED, __HIP_MEMORY_SCOPE_AGENT);
        unsigned spins = 0;
        while (__hip_atomic_load(ctr, __ATOMIC_RELAXED, __HIP_MEMORY_SCOPE_AGENT) < target) { __builtin_amdgcn_s_sleep(2); if (++spins > (1u << 24)) break; }
        __builtin_amdgcn_fence(__ATOMIC_ACQUIRE, "agent");
        asm volatile("s_waitcnt vmcnt(0)" ::: "memory");
    }
    __syncthreads();
}

__global__ void __launch_bounds__(NTHR, 2) fwd_megakernel(Args a) {
    extern __shared__ __attribute__((aligned(16))) unsigned char lds_raw[];
    cg::grid_group grid = cg::this_grid();
    Frame F;
    F.lds = (LAS unsigned char*)lds_raw;
    F.tid = threadIdx.x; F.lane = F.tid & 63; F.wave = __builtin_amdgcn_readfirstlane(F.tid >> 6);
    F.G = gridDim.x; { const int bx = blockIdx.x; F.vcu = (F.G % 8 == 0) ? (bx % 8) * (F.G / 8) + bx / 8 : bx; }
    unsigned char* ws = a.ws; unsigned char* yo = (unsigned char*)a.out;
    bf16_t* Z = (bf16_t*)(ws + WS_Z);
    bf16_t* B1 = (bf16_t*)(yo + YO_B1); bf16_t* B2 = (bf16_t*)(ws + WS_B2); bf16_t* B3 = (bf16_t*)(ws + WS_B3);
    float* SSQ = (float*)(ws + WS_SSQ);
    const int lo = a.ph_lo, hi = a.ph_hi;
#define IN(k) (lo <= (k) && (k) < hi)
#define SEAM(k) do { if (IN(k) && IN((k) + 1)) { if ((k) == 0) grid.sync(); else grid_bar((unsigned*)(ws + WS_CTL) + 64 * (k), (unsigned)F.G); } } while (0)
    pg8::StaticOrder S;

    fresh(F);
    if (IN(0)) p0_prologue(a, F);
    SEAM(0);
    if (IN(1)) {
        pg8::Gemm g{B1, (const bf16_t*)(ws + WS_WIN), DM, DM, 0}; S.init(257, 27, F.G, (int)blockIdx.x);
        pg8::EpiZ E{Z, (float*)(yo + YO_ALR), a.out};
        pg8::gemm_phase(F.lds, g, S, E);
    }
    SEAM(1);
    fresh(F);
    if (IN(2)) { for (int it = F.vcu; it < 4096; it += F.G) gla_prepass_item(a, F, it); }
    SEAM(2);
    fresh(F);
    if (IN(3)) {
        if (F.vcu < 32) gla_chain(a, F, F.vcu >> 2, F.vcu & 3);
        else {
            const int ab = F.vcu - 32, NA = F.G - 32;
            if (ab < 32) gla_sample_item(a, F, ab >> 2, ab & 3);
            for (int u = ab; u < 64 + 2048; u += NA) {
                if (u < 64) attn_unit(a, F, 1, u >> 3, u & 7, 0);
                else { const int v = u - 64; attn_unit(a, F, 0, v >> 8, (v >> 5) & 7, v & 31); }
            }
        }
    }
    SEAM(3);
    if (IN(4)) {
        { pg8::Gemm g{Z + ZRA, (const bf16_t*)(ws + WS_WBRA), ZP, 1024, 0}; S.init(257, 4, F.G, (int)blockIdx.x);
          pg8::EpiEw<1> E{B1, DM, Z + ZGA, ZP, nullptr, 0, nullptr}; pg8::gemm_phase(F.lds, g, S, E); }
        { pg8::Gemm g{Z + ZQB, (const bf16_t*)(ws + WS_WBRB), ZP, 512, 0}; S.init(257, 4, F.G, (int)blockIdx.x);
          pg8::EpiEw<2> E{B1, DM, Z + ZGB, ZP, B1, DM, nullptr}; pg8::gemm_phase(F.lds, g, S, E); }
    }
    SEAM(4);
    if (IN(5)) {
        pg8::Gemm g{B1, (const bf16_t*)(ws + WS_WOUT), DM, 1024, 0}; S.init(257, 4, F.G, (int)blockIdx.x);
        pg8::EpiEw<3> E{B2, DM, nullptr, 0, nullptr, 0, SSQ}; pg8::gemm_phase(F.lds, g, S, E);
    }
    SEAM(5);
    fresh(F);
    if (IN(6)) row_pass<true, false>(a, F, true, B2, SSQ, a.in[17], a.in[18], B3, nullptr);
    SEAM(6);
    if (IN(7)) {
        pg8::Gemm g{B3, (const bf16_t*)(ws + WS_WUP), DM, 1024, 1}; S.init(265, 22, F.G, (int)blockIdx.x);
        pg8::EpiConv E{(bf16_t*)(ws + WS_ACT), a.in[20], a.in[21], a.in[5], a.out, (LAS float*)(F.lds + XB_OFF)};
        pg8::gemm_phase(F.lds, g, S, E);
    }
    SEAM(7);
    if (IN(8)) {
        pg8::Gemm g{(const bf16_t*)(ws + WS_ACT), (const bf16_t*)(ws + WS_WDN), DFF, DFF, 0}; S.init(257, 4, F.G, (int)blockIdx.x);
        pg8::EpiEw<3> E{B2, DM, nullptr, 0, nullptr, 0, SSQ}; pg8::gemm_phase(F.lds, g, S, E);
    }
    SEAM(8);
    fresh(F);
    if (IN(9)) row_pass<true, true>(a, F, false, B2, SSQ, a.in[23], a.in[24], B3, (bf16_t*)(ws + WS_PB));
    SEAM(9);
    if (IN(10)) {
        { pg8::Gemm g{(const bf16_t*)(ws + WS_PB), (const bf16_t*)(ws + WS_WPLE), 256, 256, 0}; S.init(257, 4, F.G, (int)blockIdx.x);
          pg8::EpiEw<0> E{(bf16_t*)(ws + WS_E), DM, nullptr, 0, nullptr, 0, nullptr}; pg8::gemm_phase(F.lds, g, S, E); }
        { pg8::Gemm g{B3, (const bf16_t*)(ws + WS_WPG), DM, 1024, 0}; S.init(257, 4, F.G, (int)blockIdx.x);
          pg8::EpiEw<4> E{B2, DM, (const bf16_t*)(ws + WS_E), DM, nullptr, 0, SSQ}; pg8::gemm_phase(F.lds, g, S, E); }
    }
    SEAM(10);
    fresh(F);
    if (IN(11)) row_pass<false, false>(a, F, false, B2, SSQ, a.in[27], nullptr, nullptr, nullptr);
#undef IN
#undef SEAM
}

extern "C" void kernel_launch(void* const* d_in, const int* in_sizes, int n_in, void* d_out, int out_size, void* d_ws, size_t ws_size, hipStream_t stream) {
    static int grid = 0;
    if (grid == 0) {
        if (n_in != 28 || ws_size < WS_NEED || out_size != 74014720) { fprintf(stderr, "kernel_launch: unexpected n_in %d / ws %zu / out %d\n", n_in, ws_size, out_size); grid = -1; return; }
        int dev = 0, cus = 0, per_cu = 0;
        hipGetDevice(&dev); hipDeviceGetAttribute(&cus, hipDeviceAttributeMultiprocessorCount, dev);
        if (hipFuncSetAttribute((const void*)fwd_megakernel, hipFuncAttributeMaxDynamicSharedMemorySize, LDS_BYTES) != hipSuccess) { fprintf(stderr, "kernel_launch: hipFuncSetAttribute failed\n"); grid = -1; return; }
        if (hipOccupancyMaxActiveBlocksPerMultiprocessor(&per_cu, (const void*)fwd_megakernel, NTHR, LDS_BYTES) != hipSuccess || per_cu < 1) { fprintf(stderr, "kernel_launch: occupancy query gives %d\n", per_cu); per_cu = 1; }
        (void)hipGetLastError();
        grid = cus;
        if (grid % 8 != 0 || grid < 64) { fprintf(stderr, "kernel_launch: unexpected CU count %d\n", cus); }
    }
    if (grid < 0) return;
    if (hipMemsetAsync((char*)d_ws + WS_CTL, 0, 4096, stream) != hipSuccess) { fprintf(stderr, "kernel_launch: memset failed\n"); return; }
    Args a{};
    for (int i = 0; i < 28; ++i) a.in[i] = (const float*)d_in[i];
    a.out = (float*)d_out; a.ws = (unsigned char*)d_ws; a.ph_lo = 0; a.ph_hi = 12;
    void* args[] = {&a};
    hipError_t e = hipLaunchCooperativeKernel((const void*)fwd_megakernel, dim3(grid), dim3(NTHR), args, LDS_BYTES, stream);
    if (e != hipSuccess) fprintf(stderr, "cooperative launch failed: %s (grid %d)\n", hipGetErrorString(e), grid);
}
```

```cpp
#include <hip/hip_runtime.h>
#include <hip/hip_cooperative_groups.h>
#include <cstdio>
#include <cstdint>
namespace cg = cooperative_groups;

#define LAS __attribute__((address_space(3)))
typedef unsigned short bf16_t;
typedef short bf16x8 __attribute__((ext_vector_type(8)));
typedef float f32x4 __attribute__((ext_vector_type(4)));
typedef float f32x2 __attribute__((ext_vector_type(2)));
typedef unsigned u32x4 __attribute__((ext_vector_type(4)));
typedef unsigned u32x2 __attribute__((ext_vector_type(2)));
typedef __bf16 bf16x2_t __attribute__((ext_vector_type(2)));

constexpr int DM = 1024, TP = 65536, TSMP = 256, TT = TP + TSMP, SEQ = 8192;
constexpr int DFF = 2816;
constexpr int ZP = 6656;
constexpr int ZQA = 0, ZKA = 512, ZVA = 1024, ZRA = 2048, ZQB = 3072, ZKB = 3584, ZVB = 4096, ZGA = 4608, ZGB = 5632;
constexpr float EPS = 1e-6f;
constexpr float LOG2E = 1.4426950408889634f;
constexpr size_t O_YP = 0, O_YS = 67108864, O_KP = 67371008, O_VP = 69468160, O_SP = 71565312, O_CP = 72613888,
                 O_KS = 72658944, O_VS = 72790016, O_SS = 72921088, O_CS = 73969664;
constexpr size_t MiB = 1u << 20;
constexpr size_t WS_WIN = 0, WS_WBRA = 14 * MiB, WS_WBRB = 16 * MiB, WS_WOUT = 17 * MiB, WS_WUP = 19 * MiB, WS_WDN = 30 * MiB,
                 WS_WPG = 36 * MiB, WS_WPLE = 38 * MiB;
constexpr size_t WS_Z = 40 * MiB;
constexpr size_t WS_B2 = 876 * MiB;
constexpr size_t WS_SSQ = 1005 * MiB;
constexpr size_t WS_CTL = 1010 * MiB;
constexpr size_t WS_NEED = 1011 * MiB;
constexpr size_t WS_B3 = WS_Z;
constexpr size_t WS_ACT = WS_Z + 130 * MiB;
constexpr size_t WS_PB = WS_Z + 490 * MiB;
constexpr size_t WS_E = WS_Z + 530 * MiB;
constexpr size_t YO_B1 = 0;
constexpr size_t YO_PS = 130 * MiB;
constexpr size_t YO_DL = 164 * MiB;
constexpr size_t YO_ALR = 168 * MiB;
constexpr size_t YO_SQP = 176 * MiB;

__device__ __forceinline__ float bf2f(bf16_t b) { return __uint_as_float(((unsigned)b) << 16); }
__device__ __forceinline__ unsigned pk2(float lo, float hi) { f32x2 v = {lo, hi}; bf16x2_t b = __builtin_convertvector(v, bf16x2_t); return __builtin_bit_cast(unsigned, b); }
__device__ __forceinline__ float lo2f(unsigned u) { return __uint_as_float(u << 16); }
__device__ __forceinline__ float hi2f(unsigned u) { return __uint_as_float(u & 0xffff0000u); }
__device__ __forceinline__ float fsigmoid(float x) { return __builtin_amdgcn_rcpf(1.0f + __builtin_amdgcn_exp2f(-x * LOG2E)); }
__device__ __forceinline__ float wave_sum(float v) {
#pragma unroll
    for (int o = 1; o < 64; o <<= 1) v += __shfl_xor(v, o);
    return v;
}
#define LDS_WAIT() asm volatile("s_waitcnt lgkmcnt(0)" ::: "memory")
#define BLOCK_SYNC() __syncthreads()

namespace pg8 {
constexpr int BM = 256, BK = 64, HALF = 128, HTB = HALF * BK * 2, STAGE_BYTES = 8 * HTB, NXCD = 8, WGM = 8;
__host__ __device__ __forceinline__ int lds_byte(int r, int c) { const int st = (r >> 4) * 2 + (c >> 5), rr = r & 15, cc = c & 31, ob = rr * 64 + cc * 2; return st * 1024 + (ob ^ (((ob >> 9) & 1) << 5)); }
__host__ __device__ __forceinline__ void stage_rc(int b, int& R, int& C) { const int st = b / 1024, sb = b % 1024, swz = sb ^ (((sb >> 9) & 1) << 5); R = (st >> 1) * 16 + swz / 64; C = (st & 1) * 32 + (swz % 64) / 2; }
__host__ __device__ __forceinline__ int perm32(int rho) { const int n = rho >> 4, i = rho & 15; return 8 * (i >> 2) + 4 * n + (i & 3); }

struct Unit { int pm, pn; };
struct Gemm { const bf16_t* A; const bf16_t* Bt; int lda, K, amode; };

__device__ __forceinline__ long a_row0(int amode, int pm) {
    if (amode == 0) return (long)pm * 256;
    if (pm >= 264) return (long)TP;
    const int b = pm / 33, j = pm - b * 33;
    return (long)b * SEQ + 254 * j - 2;
}

struct StaticOrder {
    int nM, nN, nwg, G, c;
    __device__ void init(int nM_, int nN_, int G_, int c_) { nM = nM_; nN = nN_; nwg = nM * nN; G = G_; c = c_; }
    __device__ bool next(int i, Unit& u) const {
        const long L = (long)i * G + c; if (L >= nwg) return false;
        int wgid = (int)L; { const int q = nwg / NXCD, r = nwg % NXCD, xcd = wgid % NXCD, off = wgid / NXCD; wgid = (xcd < r ? xcd * (q + 1) : r * (q + 1) + (xcd - r) * q) + off; }
        const int nig = WGM * nN, gid = wgid / nig, fm = gid * WGM, gsz = (nM - fm) < WGM ? (nM - fm) : WGM;
        u.pm = fm + ((wgid % nig) % gsz); u.pn = (wgid % nig) / gsz; return true;
    }
};

template <class Epi>
__device__ __forceinline__ void gemm_phase(LAS unsigned char* lds, const Gemm g, const StaticOrder& S, const Epi& E) {
    int tid_ = threadIdx.x; asm volatile("" : "+v"(tid_));
    const int tid = tid_, wid = __builtin_amdgcn_readfirstlane(tid >> 6), lane = tid & 63, wr = wid >> 2, wc = wid & 3, fr = lane & 15, fq = lane >> 4;
    const int K = g.K, nt = K / BK, lda = g.lda;
    unsigned voffA[2], voffB[2];
#pragma unroll
    for (int i = 0; i < 2; ++i) { int R, C; stage_rc(tid * 16 + i * 8192, R, C); const int Rb = (R & ~31) + perm32(R & 31);
        voffA[i] = (unsigned)(R * lda + C) * 2u; voffB[i] = (unsigned)(Rb * K + C) * 2u; }
    const size_t kstep = (size_t)(BK * 2);
    const size_t hstepA = (size_t)HALF * lda * 2, hstepB = (size_t)HALF * K * 2;
    const size_t tstepB = 2 * hstepB;
    const unsigned ldsw = (unsigned)wid * 1024u;
    const int aoff = lds_byte(wr * 64 + fr, fq * 8), boff = lds_byte(wc * 32 + fr, fq * 8);
#define PG8_SA(b, h) (((b) * 2 + (h)) * HTB)
#define PG8_SB(b, h) ((4 + (b) * 2 + (h)) * HTB)
#define PG8_STAGE(bufoff, gbase, voff) do { _Pragma("unroll") for (int _i = 0; _i < 2; ++_i) \
        __builtin_amdgcn_global_load_lds((const unsigned*)((const char*)(gbase) + (voff)[_i]), (LAS unsigned*)(lds + (bufoff) + ldsw + _i * 8192), 16, 0, 0); } while (0)
#define PG8_LDA(dst, b, h) do { _Pragma("unroll") for (int m = 0; m < 4; ++m) _Pragma("unroll") for (int k = 0; k < 2; ++k) dst[m][k] = *(const LAS bf16x8*)(lds + PG8_SA(b, h) + aoff + m * 2048 + k * 1024); } while (0)
#define PG8_LDB(dst, b, h) do { _Pragma("unroll") for (int n = 0; n < 2; ++n) _Pragma("unroll") for (int k = 0; k < 2; ++k) dst[n][k] = *(const LAS bf16x8*)(lds + PG8_SB(b, h) + boff + n * 2048 + k * 1024); } while (0)
#define PG8_MMA(ai, bj, At, Bt) do { __builtin_amdgcn_s_setprio(1); _Pragma("unroll") for (int m = 0; m < 4; ++m) _Pragma("unroll") for (int n = 0; n < 2; ++n) _Pragma("unroll") for (int k = 0; k < 2; ++k) \
        acc[ai][bj][m][n] = __builtin_amdgcn_mfma_f32_16x16x32_bf16(Bt[n][k], At[m][k], acc[ai][bj][m][n], 0, 0, 0); __builtin_amdgcn_s_setprio(0); } while (0)
#define PG8_WAIT_V(n) asm volatile("s_waitcnt vmcnt(" #n ")" ::: "memory")
#define PG8_WAIT_L(n) asm volatile("s_waitcnt lgkmcnt(" #n ")" ::: "memory")
#define PG8_BAR __builtin_amdgcn_s_barrier()
#define PG8_SCHED __builtin_amdgcn_sched_barrier(0)
    Unit cur, nxt; int ui = 0;
    if (!S.next(0, cur)) return;
    f32x4 acc[2][2][4][2];
#pragma unroll
    for (int a = 0; a < 2; ++a)
#pragma unroll
        for (int b = 0; b < 2; ++b)
#pragma unroll
            for (int m = 0; m < 4; ++m)
#pragma unroll
                for (int n = 0; n < 2; ++n) acc[a][b][m][n] = (f32x4){0.f, 0.f, 0.f, 0.f};
    bf16x8 At[4][2], B0[2][2], B1[2][2];
    const char* cA = (const char*)g.A + a_row0(g.amode, cur.pm) * (long)lda * 2; const char* cB = (const char*)g.Bt + (size_t)cur.pn * tstepB;
    PG8_STAGE(PG8_SB(0, 0), cB, voffB); PG8_STAGE(PG8_SB(0, 1), cB + hstepB, voffB); PG8_STAGE(PG8_SA(0, 0), cA, voffA); PG8_STAGE(PG8_SA(0, 1), cA + hstepA, voffA);
    if (wr == 1) PG8_BAR;
    PG8_WAIT_V(2); PG8_BAR;
    PG8_STAGE(PG8_SB(1, 0), cB + kstep, voffB); PG8_STAGE(PG8_SA(1, 0), cA + kstep, voffA); PG8_STAGE(PG8_SB(1, 1), cB + hstepB + kstep, voffB);
    PG8_WAIT_V(6); PG8_BAR;
    for (;;) {
        const bool has_next = S.next(ui + 1, nxt);
        const char* nA = has_next ? (const char*)g.A + a_row0(g.amode, nxt.pm) * (long)lda * 2 : cA; const char* nB = has_next ? (const char*)g.Bt + (size_t)nxt.pn * tstepB : cB;
#pragma unroll 1
        for (int t = 0; t < nt; t += 2) {
            const bool last = (t == nt - 2);
            const char* a1 = cA + (size_t)(t + 1) * kstep;
            const char* a2 = last ? nA : cA + (size_t)(t + 2) * kstep; const char* b2 = last ? nB : cB + (size_t)(t + 2) * kstep;
            const char* a3 = a2 + kstep; const char* b3 = b2 + kstep;
            PG8_LDB(B0, 0, 0); PG8_LDB(B1, 0, 1); PG8_SCHED; PG8_LDA(At, 0, 0); PG8_STAGE(PG8_SA(1, 1), a1 + hstepA, voffA);
            PG8_WAIT_V(8); PG8_WAIT_L(0); PG8_BAR; PG8_MMA(0, 0, At, B0); PG8_MMA(0, 1, At, B1); PG8_BAR; PG8_SCHED;
            PG8_LDA(At, 0, 1); PG8_STAGE(PG8_SB(0, 0), b2, voffB); PG8_STAGE(PG8_SB(0, 1), b2 + hstepB, voffB); PG8_STAGE(PG8_SA(0, 0), a2, voffA);
            PG8_WAIT_V(8); PG8_WAIT_L(0); PG8_BAR; PG8_MMA(1, 0, At, B0); PG8_MMA(1, 1, At, B1); PG8_BAR; PG8_SCHED;
            PG8_LDB(B0, 1, 0); PG8_LDB(B1, 1, 1); PG8_SCHED; PG8_LDA(At, 1, 0); PG8_STAGE(PG8_SA(0, 1), a2 + hstepA, voffA);
            PG8_WAIT_V(8); PG8_WAIT_L(0); PG8_BAR; PG8_MMA(0, 0, At, B0); PG8_MMA(0, 1, At, B1); PG8_BAR; PG8_SCHED;
            PG8_LDA(At, 1, 1); PG8_STAGE(PG8_SB(1, 0), b3, voffB); PG8_STAGE(PG8_SB(1, 1), b3 + hstepB, voffB); PG8_STAGE(PG8_SA(1, 0), a3, voffA);
            PG8_WAIT_V(8); PG8_WAIT_L(0); PG8_BAR; PG8_MMA(1, 0, At, B0); PG8_MMA(1, 1, At, B1); PG8_BAR; PG8_SCHED;
        }
        if (wr == 0) PG8_BAR;
        E(acc, cur, wr, wc, fr, fq);
        if (!has_next) break;
#pragma unroll
        for (int a = 0; a < 2; ++a)
#pragma unroll
            for (int b = 0; b < 2; ++b)
#pragma unroll
                for (int m = 0; m < 4; ++m)
#pragma unroll
                    for (int n = 0; n < 2; ++n) acc[a][b][m][n] = (f32x4){0.f, 0.f, 0.f, 0.f};
        cur = nxt; cA = nA; cB = nB; ++ui;
        if (wr == 1) PG8_BAR;
    }
    PG8_WAIT_V(0);
    PG8_BAR;
#undef PG8_SA
#undef PG8_SB
#undef PG8_STAGE
#undef PG8_LDA
#undef PG8_LDB
#undef PG8_MMA
#undef PG8_WAIT_V
#undef PG8_WAIT_L
#undef PG8_SCHED
}

struct EpiZ {
    bf16_t* Z; float* alr; float* out;
    __device__ __forceinline__ void operator()(const f32x4 (&acc)[2][2][4][2], const Unit& u, int wr, int wc, int fr, int fq) const {
        asm volatile("" : "+v"(fr), "+v"(fq));
        const int row0 = u.pm * BM + wr * 64 + fr;
        if (u.pn == 26) {
            if (wc == 0 && fq < 2) {
#pragma unroll
                for (int ai = 0; ai < 2; ++ai)
#pragma unroll
                    for (int m = 0; m < 4; ++m)
#pragma unroll
                        for (int n = 0; n < 2; ++n) *(f32x4*)(alr + (size_t)(row0 + ai * HALF + m * 16) * 16 + 8 * fq + 4 * n) = acc[ai][0][m][n];
            }
            return;
        }
        const int colt = u.pn * BM;
        float sc = 1.f; if (colt < 512) sc = 0.08838834764831845f; else if (colt >= ZQB && colt < ZKB) sc = 0.125f * LOG2E;
        float* fo = nullptr; long frow0 = 0;
        if (colt >= ZKB && colt < ZGA) {
            const bool isv = colt >= ZVB; const int cc = colt - (isv ? ZVB : ZKB);
            if (u.pm == 256) { fo = out + (isv ? O_VS : O_KS) + cc; frow0 = 0; }
            else if ((u.pm & 31) >= 30) { fo = out + (isv ? O_VP : O_KP) + cc; frow0 = (long)(u.pm >> 5) * 512 + ((u.pm & 31) - 30) * 256; }
        }
        const int colw = wc * 32 + 8 * fq;
#pragma unroll
        for (int ai = 0; ai < 2; ++ai)
#pragma unroll
            for (int m = 0; m < 4; ++m) {
                const int rt = ai * HALF + wr * 64 + m * 16 + fr;
                bf16_t* rowp = Z + (size_t)(u.pm * BM + rt) * ZP + colt + colw;
#pragma unroll
                for (int bj = 0; bj < 2; ++bj) {
                    const f32x4 v0 = acc[ai][bj][m][0] * sc, v1 = acc[ai][bj][m][1] * sc;
                    u32x4 w; w.x = pk2(v0[0], v0[1]); w.y = pk2(v0[2], v0[3]); w.z = pk2(v1[0], v1[1]); w.w = pk2(v1[2], v1[3]);
                    *(u32x4*)(rowp + bj * HALF) = w;
                    if (fo) { float* fp = fo + (size_t)(frow0 + rt) * 512 + colw + bj * HALF; *(f32x4*)fp = v0; *(f32x4*)(fp + 4) = v1; }
                }
                asm volatile("" ::: "memory");
            }
    }
};

template <int MODE> struct EpiEw {
    bf16_t* O; int ldo; const bf16_t* X1; int ld1; const bf16_t* X2; int ld2; float* ssq;
    __device__ __forceinline__ void operator()(const f32x4 (&acc)[2][2][4][2], const Unit& u, int wr, int wc, int fr, int fq) const {
        asm volatile("" : "+v"(fr), "+v"(fq));
        const int col0 = u.pn * BM + wc * 32 + 8 * fq;
#pragma unroll
        for (int ai = 0; ai < 2; ++ai)
#pragma unroll
            for (int m = 0; m < 4; ++m) {
                const size_t row = (size_t)u.pm * BM + ai * HALF + wr * 64 + m * 16 + fr;
                float ss = 0.f;
#pragma unroll
                for (int bj = 0; bj < 2; ++bj) {
                    const int col = col0 + bj * HALF;
                    float v[8];
#pragma unroll
                    for (int e = 0; e < 4; ++e) { v[e] = acc[ai][bj][m][0][e]; v[4 + e] = acc[ai][bj][m][1][e]; }
                    if (MODE == 1 || MODE == 2 || MODE == 4) {
                        const u32x4 a = *(const u32x4*)(X1 + row * ld1 + col);
                        float x[8] = {lo2f(a.x), hi2f(a.x), lo2f(a.y), hi2f(a.y), lo2f(a.z), hi2f(a.z), lo2f(a.w), hi2f(a.w)};
                        if (MODE == 4) {
#pragma unroll
                            for (int e = 0; e < 8; ++e) v[e] = fsigmoid(v[e]) * x[e];
                        } else {
#pragma unroll
                            for (int e = 0; e < 8; ++e) v[e] = fsigmoid(x[e]) * v[e];
                        }
                    }
                    if (MODE == 2) {
                        const u32x4 a = *(const u32x4*)(X2 + row * ld2 + col);
                        float x[8] = {lo2f(a.x), hi2f(a.x), lo2f(a.y), hi2f(a.y), lo2f(a.z), hi2f(a.z), lo2f(a.w), hi2f(a.w)};
#pragma unroll
                        for (int e = 0; e < 8; ++e) v[e] += x[e];
                    }
                    u32x4 w; w.x = pk2(v[0], v[1]); w.y = pk2(v[2], v[3]); w.z = pk2(v[4], v[5]); w.w = pk2(v[6], v[7]);
                    *(u32x4*)(O + row * ldo + col) = w;
                    if (MODE == 3 || MODE == 4) {
#pragma unroll
                        for (int e = 0; e < 8; ++e) ss += v[e] * v[e];
                    }
                }
                if (MODE == 3 || MODE == 4) {
                    ss += __shfl_xor(ss, 16); ss += __shfl_xor(ss, 32);
                    if (fq == 0) ssq[row * 16 + u.pn * 4 + wc] = ss;
                }
                asm volatile("" ::: "memory");
            }
    }
};

__device__ __forceinline__ float dpp_ror1(float v) { return __builtin_bit_cast(float, __builtin_amdgcn_update_dpp(0, __builtin_bit_cast(int, v), 0x121, 0xf, 0xf, false)); }
__device__ __forceinline__ float dpp_ror2(float v) { return __builtin_bit_cast(float, __builtin_amdgcn_update_dpp(0, __builtin_bit_cast(int, v), 0x122, 0xf, 0xf, false)); }
struct EpiConv {
    bf16_t* ACT; const float* convw; const float* convb; const float* state_conv; float* out; LAS float* xb;
    __device__ __forceinline__ void operator()(f32x4 (&acc)[2][2][4][2], const Unit& u, int wr, int wc, int fr, int fq) const {
        asm volatile("" : "+v"(fr), "+v"(fq));
        const bool samp = (u.pm >= 264);
        const int bq = samp ? 0 : u.pm / 33, j = samp ? 0 : u.pm - bq * 33;
        const int trow0 = 254 * j - 2;
        const int c0 = wc * 32 + 8 * fq, ch0 = u.pn * 128 + c0;
        if (!samp && j == 0 && wr == 0 && fr < 2) { acc[0][1][0][0] = (f32x4){0.f, 0.f, 0.f, 0.f}; acc[0][1][0][1] = (f32x4){0.f, 0.f, 0.f, 0.f}; }
        if (fr >= 14) {
#pragma unroll
            for (int ai = 0; ai < 2; ++ai)
#pragma unroll
                for (int n = 0; n < 2; ++n) *(LAS f32x4*)(xb + ((2 * ai + wr) * 2 + (fr - 14)) * 128 + c0 + 4 * n) = acc[ai][1][3][n];
        }
        asm volatile("s_waitcnt lgkmcnt(0)" ::: "memory"); __builtin_amdgcn_s_barrier(); asm volatile("" ::: "memory");
#pragma unroll
        for (int n = 0; n < 2; ++n) {
            const f32x4 w0 = *(const f32x4*)(convw + ch0 + 4 * n), w1 = *(const f32x4*)(convw + DFF + ch0 + 4 * n), w2 = *(const f32x4*)(convw + 2 * DFF + ch0 + 4 * n), cb = *(const f32x4*)(convb + ch0 + 4 * n);
#pragma unroll
            for (int ai = 0; ai < 2; ++ai)
#pragma unroll
                for (int m = 0; m < 4; ++m) {
                    const int r = ai * HALF + wr * 64 + m * 16 + fr;
                    f32x4 pv;
                    if (samp && (m & 1) == 0) pv = *(const f32x4*)(state_conv + (size_t)((r >> 5) * 2 + (fr & 1)) * DFF + ch0 + 4 * n);
                    else if (m == 0) { const int blk = 2 * ai + wr; pv = blk > 0 ? *(const LAS f32x4*)(xb + ((blk - 1) * 2 + (fr & 1)) * 128 + c0 + 4 * n) : (f32x4){0.f, 0.f, 0.f, 0.f}; }
                    else pv = acc[ai][1][m - 1][n];
                    float y[4];
#pragma unroll
                    for (int e = 0; e < 4; ++e) {
                        const float G = acc[ai][1][m][n][e];
                        const float x1 = dpp_ror1(G), x2 = dpp_ror2(G), p1 = dpp_ror1(pv[e]), p2 = dpp_ror2(pv[e]);
                        const float gm1 = fr >= 1 ? x1 : p1, gm2 = fr >= 2 ? x2 : p2;
                        const float gc = cb[e] + w0[e] * gm2 + w1[e] * gm1 + w2[e] * G;
                        const float uu = 0.7978845608028654f * (gc + 0.044715f * gc * gc * gc);
                        const float ge = gc * __builtin_amdgcn_rcpf(1.0f + __builtin_amdgcn_exp2f(-2.0f * LOG2E * uu));
                        y[e] = ge * acc[ai][0][m][n][e];
                    }
                    u32x2 w; w.x = pk2(y[0], y[1]); w.y = pk2(y[2], y[3]);
                    if (samp) {
                        *(u32x2*)(ACT + (size_t)(TP + r) * DFF + ch0 + 4 * n) = w;
                        const int t = r & 31;
                        if (t >= 30) *(f32x4*)(out + O_CS + (size_t)((r >> 5) * 2 + (t - 30)) * DFF + ch0 + 4 * n) = acc[ai][1][m][n];
                    } else {
                        const int t = trow0 + r;
                        if (r >= 2 && t < SEQ) {
                            *(u32x2*)(ACT + (size_t)(bq * SEQ + t) * DFF + ch0 + 4 * n) = w;
                            if (t >= SEQ - 2) *(f32x4*)(out + O_CP + (size_t)(bq * 2 + (t - (SEQ - 2))) * DFF + ch0 + 4 * n) = acc[ai][1][m][n];
                        }
                    }
                    asm volatile("" ::: "memory");
                }
        }
        asm volatile("s_waitcnt lgkmcnt(0)" ::: "memory"); __builtin_amdgcn_s_barrier(); asm volatile("" ::: "memory");
    }
};
#undef PG8_BAR
}

#ifndef PROBE_REP1
#define PROBE_REP1 1
#endif
#ifndef PROBE_REP7
#define PROBE_REP7 1
#endif
constexpr int NWAVES = 8, NTHR = 512;
constexpr int RING_BYTES = 131072, XB_OFF = RING_BYTES, LDS_BYTES = 147456;

struct Args {
    const float* in[28]; float* out; unsigned char* ws; int ph_lo, ph_hi;
};
struct Frame {
    LAS unsigned char* lds; int tid, lane, wave, vcu, G;
};
__device__ __forceinline__ void fresh(Frame& F) { int t = threadIdx.x; asm volatile("" : "+v"(t)); F.tid = t; F.lane = t & 63; F.wave = __builtin_amdgcn_readfirstlane(t >> 6); }

__device__ __forceinline__ void transpose_item(const float* W, int ldw, int K, bf16_t* WT, int k0, int c_src, int r_dst, int nvalid, LAS float* scr, int lane) {
#pragma unroll 8
    for (int i = 0; i < 32; ++i) { const int kk = 2 * i + (lane >> 5); const int c = lane & 31; scr[kk * 33 + c] = (c < nvalid) ? W[(size_t)(k0 + kk) * ldw + c_src + c] : 0.f; }
    LDS_WAIT(); asm volatile("" ::: "memory");
    const int c = lane & 7;
#pragma unroll
    for (int jj = 0; jj < 4; ++jj) { const int n = (lane >> 3) + 8 * jj; const LAS float* s = scr + (8 * c) * 33 + n;
        u32x4 o; o.x = pk2(s[0 * 33], s[1 * 33]); o.y = pk2(s[2 * 33], s[3 * 33]); o.z = pk2(s[4 * 33], s[5 * 33]); o.w = pk2(s[6 * 33], s[7 * 33]);
        *(u32x4*)(WT + (size_t)(r_dst + n) * K + k0 + 8 * c) = o; }
    LDS_WAIT(); asm volatile("" ::: "memory");
}

__device__ __forceinline__ const float* xrow_ptr(const Args& a, int m) { return m < TP ? a.in[0] + (size_t)m * DM : a.in[1] + (size_t)(m - TP) * DM; }

__device__ __forceinline__ void p0_prologue(const Args& a, Frame& F) {
    LAS float* scr = (LAS float*)(F.lds + F.wave * 16384);
    const int gw = F.vcu * NWAVES + F.wave, NGW = F.G * NWAVES;
    unsigned char* ws = a.ws;
    constexpr int I_IN = 16 * 216, I_BRA = 16 * 32, I_BRB = 8 * 32, I_OUT = 16 * 32, I_UP = 16 * 176, I_DN = 44 * 32, I_PG = 16 * 32, I_PLE = 4 * 32;
    constexpr int NITEMS = I_IN + I_BRA + I_BRB + I_OUT + I_UP + I_DN + I_PG + I_PLE;
    for (int it = gw; it < NITEMS; it += NGW) {
        int r = it;
        if (r < I_IN) { const int kb = r / 216, nb = r % 216; const int dst = nb * 32;
            int src, nv = 32; if (dst < 3072) src = dst; else if (dst < 6656) src = dst + 16; else if (dst == 6656) { src = 3072; nv = 16; } else { src = 0; nv = 0; }
            transpose_item(a.in[9], 6672, 1024, (bf16_t*)(ws + WS_WIN), kb * 64, src, dst, nv, scr, F.lane); continue; } r -= I_IN;
        if (r < I_BRA) { transpose_item(a.in[14], 1024, 1024, (bf16_t*)(ws + WS_WBRA), (r / 32) * 64, (r % 32) * 32, (r % 32) * 32, 32, scr, F.lane); continue; } r -= I_BRA;
        if (r < I_BRB) { transpose_item(a.in[15], 1024, 512, (bf16_t*)(ws + WS_WBRB), (r / 32) * 64, (r % 32) * 32, (r % 32) * 32, 32, scr, F.lane); continue; } r -= I_BRB;
        if (r < I_OUT) { transpose_item(a.in[16], 1024, 1024, (bf16_t*)(ws + WS_WOUT), (r / 32) * 64, (r % 32) * 32, (r % 32) * 32, 32, scr, F.lane); continue; } r -= I_OUT;
        if (r < I_UP) { const int kb = r / 176, nb = r % 176; const int tile = nb >> 3, sub = nb & 7;
            const int src = sub < 4 ? 128 * tile + 32 * sub : DFF + 128 * tile + 32 * (sub - 4);
            transpose_item(a.in[19], 2 * DFF, 1024, (bf16_t*)(ws + WS_WUP), kb * 64, src, nb * 32, 32, scr, F.lane); continue; } r -= I_UP;
        if (r < I_DN) { transpose_item(a.in[22], 1024, DFF, (bf16_t*)(ws + WS_WDN), (r / 32) * 64, (r % 32) * 32, (r % 32) * 32, 32, scr, F.lane); continue; } r -= I_DN;
        if (r < I_PG) { transpose_item(a.in[25], 1024, 1024, (bf16_t*)(ws + WS_WPG), (r / 32) * 64, (r % 32) * 32, (r % 32) * 32, 32, scr, F.lane); continue; } r -= I_PG;
        transpose_item(a.in[26], 1024, 256, (bf16_t*)(ws + WS_WPLE), (r / 32) * 64, (r % 32) * 32, (r % 32) * 32, 32, scr, F.lane);
    }
    bf16_t* H0 = (bf16_t*)((unsigned char*)a.out + YO_B1);
    const float* gp = a.in[8];
    f32x4 gv[4];
#pragma unroll
    for (int j = 0; j < 4; ++j) gv[j] = *((const f32x4*)gp + F.lane + 64 * j);
    for (int m = gw; m < TT; m += NGW) {
        const f32x4* xr = (const f32x4*)xrow_ptr(a, m) + F.lane;
        f32x4 v[4]; float s = 0.f;
#pragma unroll
        for (int j = 0; j < 4; ++j) { v[j] = xr[64 * j]; s += (v[j].x * v[j].x + v[j].y * v[j].y) + (v[j].z * v[j].z + v[j].w * v[j].w); }
        const float rstd = 1.0f / sqrtf(wave_sum(s) * (1.f / DM) + EPS);
        u32x2* o8 = (u32x2*)(H0 + (size_t)m * DM) + F.lane;
#pragma unroll
        for (int j = 0; j < 4; ++j) { u32x2 w; w.x = pk2(v[j].x * rstd * gv[j].x, v[j].y * rstd * gv[j].y); w.y = pk2(v[j].z * rstd * gv[j].z, v[j].w * rstd * gv[j].w); o8[64 * j] = w; }
    }
}

template <bool HAS_H, bool HAS_PB>
__device__ __forceinline__ void row_pass(const Args& a, Frame& F, bool x_from_input, const bf16_t* BR, const float* ssq, const float* gpost, const float* gpre, bf16_t* HO, bf16_t* PB) {
    const int gw = F.vcu * NWAVES + F.wave, NGW = F.G * NWAVES;
    float* X = a.out;
    f32x4 g1[4], g2[4];
#pragma unroll
    for (int j = 0; j < 4; ++j) { g1[j] = *((const f32x4*)gpost + F.lane + 64 * j); if (HAS_H) g2[j] = *((const f32x4*)gpre + F.lane + 64 * j); }
    for (int m = gw; m < TT; m += NGW) {
        const f32x4* xr = (const f32x4*)(x_from_input ? xrow_ptr(a, m) : X + (size_t)m * DM) + F.lane;
        const u32x2* br = (const u32x2*)(BR + (size_t)m * DM) + F.lane;
        const f32x4 sq0 = *(const f32x4*)(ssq + (size_t)m * 16), sq1 = *(const f32x4*)(ssq + (size_t)m * 16 + 4), sq2 = *(const f32x4*)(ssq + (size_t)m * 16 + 8), sq3 = *(const f32x4*)(ssq + (size_t)m * 16 + 12);
        const float tot = ((sq0.x + sq0.y) + (sq0.z + sq0.w)) + ((sq1.x + sq1.y) + (sq1.z + sq1.w)) + ((sq2.x + sq2.y) + (sq2.z + sq2.w)) + ((sq3.x + sq3.y) + (sq3.z + sq3.w));
        const float rs = 1.0f / sqrtf(tot * (1.f / DM) + EPS);
        f32x4 v[4]; float s = 0.f;
#pragma unroll
        for (int j = 0; j < 4; ++j) { const f32x4 x = xr[64 * j]; const u32x2 b = br[64 * j];
            v[j].x = x.x + lo2f(b.x) * rs * g1[j].x; v[j].y = x.y + hi2f(b.x) * rs * g1[j].y; v[j].z = x.z + lo2f(b.y) * rs * g1[j].z; v[j].w = x.w + hi2f(b.y) * rs * g1[j].w;
            s += (v[j].x * v[j].x + v[j].y * v[j].y) + (v[j].z * v[j].z + v[j].w * v[j].w); }
        f32x4* xo = (f32x4*)(X + (size_t)m * DM) + F.lane;
#pragma unroll
        for (int j = 0; j < 4; ++j) xo[64 * j] = v[j];
        if (HAS_H) {
            const float rstd = 1.0f / sqrtf(wave_sum(s) * (1.f / DM) + EPS);
            u32x2* o8 = (u32x2*)(HO + (size_t)m * DM) + F.lane;
#pragma unroll
            for (int j = 0; j < 4; ++j) { u32x2 w; w.x = pk2(v[j].x * rstd * g2[j].x, v[j].y * rstd * g2[j].y); w.y = pk2(v[j].z * rstd * g2[j].z, v[j].w * rstd * g2[j].w); o8[64 * j] = w; }
        }
        if (HAS_PB) {
            const float* pe = m < TP ? a.in[6] + (size_t)m * 256 : a.in[7] + (size_t)(m - TP) * 256;
            const f32x4 p = *((const f32x4*)pe + F.lane);
            u32x2 w; w.x = pk2(p.x, p.y); w.y = pk2(p.z, p.w);
            *((u32x2*)(PB + (size_t)m * 256) + F.lane) = w;
        }
    }
}

__device__ __forceinline__ float log_sigmoid(float x) {
    const float e = __builtin_amdgcn_exp2f(-fabsf(x) * LOG2E);
    return fminf(x, 0.f) - __builtin_amdgcn_logf(1.0f + e) * 0.6931471805599453f;
}

__device__ __forceinline__ void gla_prepass_item(const Args& a, Frame& F, int item) {
    const int n = item & 127, h = (item >> 7) & 3, b = item >> 9;
    const size_t row0 = (size_t)b * SEQ + 64 * n;
    bf16_t* Z = (bf16_t*)(a.ws + WS_Z);
    const float* alr = (const float*)((unsigned char*)a.out + YO_ALR);
    bf16_t* PS = (bf16_t*)((unsigned char*)a.out + YO_PS) + (size_t)item * 4096;
    float* DL = (float*)((unsigned char*)a.out + YO_DL) + (size_t)item * 128;
    LAS float* AL = (LAS float*)(F.lds);
    LAS float* WA = (LAS float*)(F.lds + 4096);
    LAS float* BA = (LAS float*)(F.lds + 12288);
    LAS float* GS = (LAS float*)(F.lds + 12800);
    LAS bf16_t* QL = (LAS bf16_t*)(F.lds + 16384);
    LAS bf16_t* KL = (LAS bf16_t*)(F.lds + 16384 + 17408);
    LAS bf16_t* VL = (LAS bf16_t*)(F.lds + 16384 + 2 * 17408);
    LAS bf16_t* QR = (LAS bf16_t*)(F.lds + 16384 + 2 * 17408 + 33792);
    LAS bf16_t* KR = (LAS bf16_t*)(F.lds + 16384 + 3 * 17408 + 33792);
    const int tid = F.tid;
    if (tid < 256) *(LAS f32x4*)(AL + tid * 4) = *(const f32x4*)(alr + row0 * 16 + tid * 4);
    { const int r = tid >> 5, c4 = (tid & 31) * 4; *(LAS f32x4*)(WA + r * 128 + c4) = *(const f32x4*)(a.in[10] + (size_t)r * 512 + h * 128 + c4); }
    if (tid < 128) BA[tid] = a.in[11][h * 128 + tid];
#pragma unroll
    for (int i = 0; i < 4; ++i) { const int c = tid + 512 * i; const int t = c >> 5, d8 = (c & 31) * 8;
        *(LAS u32x4*)(VL + t * 264 + d8) = *(const u32x4*)(Z + (row0 + t) * ZP + ZVA + h * 256 + d8); }
#pragma unroll
    for (int i = 0; i < 2; ++i) { const int cc = tid + 512 * i; const int t = cc >> 4, c8 = (cc & 15) * 8;
        *(LAS u32x4*)(QR + t * 136 + c8) = *(const u32x4*)(Z + (row0 + t) * ZP + ZQA + h * 128 + c8);
        *(LAS u32x4*)(KR + t * 136 + c8) = *(const u32x4*)(Z + (row0 + t) * ZP + ZKA + h * 128 + c8); }
    BLOCK_SYNC();
    const int c = tid & 127, tg = tid >> 7;
    float cs[16];
    {
        float wv[16];
#pragma unroll
        for (int r = 0; r < 16; ++r) wv[r] = WA[r * 128 + c];
        const float bb = BA[c];
        float run = 0.f;
#pragma unroll
        for (int i = 0; i < 16; ++i) {
            const int t = tg * 16 + i; float d = bb;
#pragma unroll
            for (int r4 = 0; r4 < 4; ++r4) { const f32x4 av = *(const LAS f32x4*)(AL + t * 16 + r4 * 4); d += av.x * wv[r4 * 4] + av.y * wv[r4 * 4 + 1] + av.z * wv[r4 * 4 + 2] + av.w * wv[r4 * 4 + 3]; }
            run += log_sigmoid(d) * (1.0f / 16.0f); cs[i] = run;
        }
        GS[tg * 128 + c] = run;
    }
    BLOCK_SYNC();
    {
        float off = 0.f;
#pragma unroll
        for (int g2 = 0; g2 < 3; ++g2) if (g2 < tg) off += GS[g2 * 128 + c];
#pragma unroll
        for (int i = 0; i < 16; ++i) {
            const int t = tg * 16 + i; const float bcum = cs[i] + off;
            const float eb = __builtin_amdgcn_exp2f(bcum * LOG2E), enb = __builtin_amdgcn_exp2f(-bcum * LOG2E);
            const float q = bf2f(QR[t * 136 + c]), k = bf2f(KR[t * 136 + c]);
            QL[t * 136 + c] = (bf16_t)(pk2(q * eb, 0.f) & 0xffffu); KL[t * 136 + c] = (bf16_t)(pk2(k * enb, 0.f) & 0xffffu);
            if (t == 63) DL[c] = eb;
        }
    }
    BLOCK_SYNC();
    {
        const int lr = F.lane & 15, g = F.lane >> 4, mt = F.wave >> 1;
#pragma unroll
        for (int jj = 0; jj < 2; ++jj) {
            const int jt = 2 * (F.wave & 1) + jj;
            f32x4 s = {0.f, 0.f, 0.f, 0.f};
#pragma unroll
            for (int ks = 0; ks < 4; ++ks) {
                const bf16x8 kf = *(const LAS bf16x8*)(KL + (16 * jt + lr) * 136 + 32 * ks + 8 * g);
                const bf16x8 qf = *(const LAS bf16x8*)(QL + (16 * mt + lr) * 136 + 32 * ks + 8 * g);
                s = __builtin_amdgcn_mfma_f32_16x16x32_bf16(kf, qf, s, 0, 0, 0);
            }
            const int i = 16 * mt + lr, j0 = 16 * jt + 4 * g;
            float v0 = (j0 + 0 <= i) ? s[0] : 0.f, v1 = (j0 + 1 <= i) ? s[1] : 0.f, v2 = (j0 + 2 <= i) ? s[2] : 0.f, v3 = (j0 + 3 <= i) ? s[3] : 0.f;
            u32x2 w; w.x = pk2(v0, v1); w.y = pk2(v2, v3);
            *(u32x2*)(PS + i * 64 + j0) = w;
        }
    }
#pragma unroll
    for (int i = 0; i < 2; ++i) { const int cc = tid + 512 * i; const int t = cc >> 4, p8 = cc & 15, s = p8 >> 2, g = p8 & 3;
        const u32x2 lo = *(const LAS u32x2*)(QL + t * 136 + 32 * s + 4 * g), hi = *(const LAS u32x2*)(QL + t * 136 + 32 * s + 16 + 4 * g);
        u32x4 w; w.x = lo.x; w.y = lo.y; w.z = hi.x; w.w = hi.y;
        *(u32x4*)(Z + (row0 + t) * ZP + ZQA + h * 128 + 8 * p8) = w; }
#pragma unroll
    for (int i = 0; i < 2; ++i) { const int cc = tid + 512 * i; const int ch = cc >> 3, t8 = cc & 7;
        unsigned e[8];
#pragma unroll
        for (int q = 0; q < 8; ++q) e[q] = KL[(8 * t8 + q) * 136 + ch];
        u32x4 w; w.x = e[0] | (e[1] << 16); w.y = e[2] | (e[3] << 16); w.z = e[4] | (e[5] << 16); w.w = e[6] | (e[7] << 16);
        *(u32x4*)(Z + (row0 + (ch >> 1)) * ZP + ZKA + h * 128 + (ch & 1) * 64 + 8 * t8) = w; }
#pragma unroll
    for (int i = 0; i < 4; ++i) { const int cc = tid + 512 * i; const int dv = cc >> 3, t8 = cc & 7;
        unsigned e[8];
#pragma unroll
        for (int q = 0; q < 8; ++q) e[q] = VL[(8 * t8 + q) * 264 + dv];
        u32x4 w; w.x = e[0] | (e[1] << 16); w.y = e[2] | (e[3] << 16); w.z = e[4] | (e[5] << 16); w.w = e[6] | (e[7] << 16);
        *(u32x4*)(Z + (row0 + (dv >> 2)) * ZP + ZVA + h * 256 + (dv & 3) * 64 + 8 * t8) = w; }
    BLOCK_SYNC();
}

__device__ __forceinline__ float dpp_sum16(float v) {
    v += __builtin_bit_cast(float, __builtin_amdgcn_update_dpp(0, __builtin_bit_cast(int, v), 0xB1, 0xf, 0xf, false));
    v += __builtin_bit_cast(float, __builtin_amdgcn_update_dpp(0, __builtin_bit_cast(int, v), 0x4E, 0xf, 0xf, false));
    v += __builtin_bit_cast(float, __builtin_amdgcn_update_dpp(0, __builtin_bit_cast(int, v), 0x141, 0xf, 0xf, false));
    v += __builtin_bit_cast(float, __builtin_amdgcn_update_dpp(0, __builtin_bit_cast(int, v), 0x128, 0xf, 0xf, false));
    return v;
}
__device__ __forceinline__ void gla_chain(const Args& a, Frame& F, int b, int h, int half) {
    const bf16_t* Z = (const bf16_t*)(a.ws + WS_Z);
    bf16_t* ORAW = (bf16_t*)(a.ws + WS_B2);
    float* SQP = (float*)((unsigned char*)a.out + YO_SQP);
    const bf16_t* PSg = (const bf16_t*)((unsigned char*)a.out + YO_PS);
    const float* DLg = (const float*)((unsigned char*)a.out + YO_DL);
    constexpr int BUFB = 40960;
    LAS float* DLs = (LAS float*)(F.lds + 2 * BUFB);
    const int tid = F.tid, lane = F.lane, w = F.wave, lr = lane & 15, g = lane >> 4;
    const int dv0 = 128 * half + 16 * w;
    f32x4 S[8];
#pragma unroll
    for (int mt = 0; mt < 8; ++mt) S[mt] = (f32x4){0.f, 0.f, 0.f, 0.f};
    f32x4 sd = {0.f, 0.f, 0.f, 0.f}; bf16x8 Vn[2], Vf[2];
    size_t qsrc[2], ksrc[2]; int psrc;
#pragma unroll
    for (int i = 0; i < 2; ++i) {
        const int q = 2 * w + i;
        { const int r = 4 * q + (lane >> 4), p = (lane & 15) ^ (r & 15); qsrc[i] = (size_t)r * ZP + ZQA + h * 128 + 8 * p; }
        { const int ch = 8 * q + (lane >> 3), p = (lane & 7) ^ (ch & 7); ksrc[i] = (size_t)(ch >> 1) * ZP + ZKA + h * 128 + (ch & 1) * 64 + 8 * p; }
    }
    { const int i = 8 * w + (lane >> 3), p = (lane & 7) ^ (i & 7); psrc = i * 64 + 8 * p; }
#define GC_DMA(nn, bufi) do { const size_t r0_ = (size_t)b * SEQ + 64 * (nn); const int item_ = (b * 4 + h) * 128 + (nn); LAS unsigned char* B_ = F.lds + (bufi) * BUFB; \
        _Pragma("unroll") for (int i_ = 0; i_ < 2; ++i_) { \
            __builtin_amdgcn_global_load_lds((const unsigned*)(Z + r0_ * ZP + qsrc[i_]), (LAS unsigned*)(B_ + (2 * w + i_) * 1024), 16, 0, 0); \
            __builtin_amdgcn_global_load_lds((const unsigned*)(Z + r0_ * ZP + ksrc[i_]), (LAS unsigned*)(B_ + 16384 + (2 * w + i_) * 1024), 16, 0, 0); } \
        __builtin_amdgcn_global_load_lds((const unsigned*)(PSg + (size_t)item_ * 4096 + psrc), (LAS unsigned*)(B_ + 32768 + w * 1024), 16, 0, 0); \
        if (tid < 32) sd = *(const f32x4*)(DLg + (size_t)item_ * 128 + 4 * tid); \
        _Pragma("unroll") for (int ks_ = 0; ks_ < 2; ++ks_) { const int dv_ = dv0 + lr; \
            Vn[ks_] = *(const bf16x8*)(Z + (r0_ + (dv_ >> 2)) * ZP + ZVA + h * 256 + (dv_ & 3) * 64 + 32 * ks_ + 8 * g); } } while (0)
    GC_DMA(0, 0);
    if (tid < 32) *(LAS f32x4*)(DLs + 4 * tid) = sd;
    Vf[0] = Vn[0]; Vf[1] = Vn[1];
    asm volatile("s_waitcnt vmcnt(0)" ::: "memory");
    BLOCK_SYNC();
    for (int n = 0; n < 128; ++n) {
        const int bi = n & 1;
        const size_t row0 = (size_t)b * SEQ + 64 * n;
        if (n + 1 < 128) GC_DMA(n + 1, bi ^ 1);
        const LAS unsigned char* QL = F.lds + bi * BUFB;
        const LAS unsigned char* KT = F.lds + bi * BUFB + 16384;
        const LAS unsigned char* PL = F.lds + bi * BUFB + 32768;
        f32x4 o[4];
#pragma unroll
        for (int mt = 0; mt < 4; ++mt) o[mt] = (f32x4){0.f, 0.f, 0.f, 0.f};
#pragma unroll
        for (int ks = 0; ks < 2; ++ks)
#pragma unroll
            for (int mt = 0; mt < 4; ++mt) {
                const bf16x8 pf = *(const LAS bf16x8*)(PL + (16 * mt + lr) * 128 + (((4 * ks + g) ^ (lr & 7)) << 4));
                o[mt] = __builtin_amdgcn_mfma_f32_16x16x32_bf16(pf, Vf[ks], o[mt], 0, 0, 0);
            }
#pragma unroll
        for (int s = 0; s < 4; ++s) {
            u32x4 t; t.x = pk2(S[2 * s][0], S[2 * s][1]); t.y = pk2(S[2 * s][2], S[2 * s][3]); t.z = pk2(S[2 * s + 1][0], S[2 * s + 1][1]); t.w = pk2(S[2 * s + 1][2], S[2 * s + 1][3]);
            const bf16x8 sb = __builtin_bit_cast(bf16x8, t);
#pragma unroll
            for (int mt = 0; mt < 4; ++mt) {
                const bf16x8 qf = *(const LAS bf16x8*)(QL + (16 * mt + lr) * 256 + (((4 * s + g) ^ lr) << 4));
                o[mt] = __builtin_amdgcn_mfma_f32_16x16x32_bf16(qf, sb, o[mt], 0, 0, 0);
            }
        }
#pragma unroll
        for (int mt = 0; mt < 8; ++mt) {
#pragma unroll
            for (int ks = 0; ks < 2; ++ks) {
                const bf16x8 kf = *(const LAS bf16x8*)(KT + (16 * mt + lr) * 128 + (((4 * ks + g) ^ (lr & 7)) << 4));
                S[mt] = __builtin_amdgcn_mfma_f32_16x16x32_bf16(kf, Vf[ks], S[mt], 0, 0, 0);
            }
            const f32x4 dd = *(const LAS f32x4*)(DLs + bi * 128 + 16 * mt + 4 * g);
            S[mt] = S[mt] * dd;
        }
#pragma unroll
        for (int mt = 0; mt < 4; ++mt)
#pragma unroll
            for (int i = 0; i < 4; ++i) {
                const size_t row = row0 + 16 * mt + 4 * g + i;
                ORAW[row * DM + h * 256 + dv0 + lr] = (bf16_t)(pk2(o[mt][i], 0.f) & 0xffffu);
                const float p = dpp_sum16(o[mt][i] * o[mt][i]);
                if (lr == 0) SQP[(row * 4 + h) * 16 + half * 8 + w] = p;
            }
        if (tid < 32) *(LAS f32x4*)(DLs + (bi ^ 1) * 128 + 4 * tid) = sd;
        Vf[0] = Vn[0]; Vf[1] = Vn[1];
        asm volatile("s_waitcnt vmcnt(0)" ::: "memory");
        BLOCK_SYNC();
    }
#undef GC_DMA
    float* so = a.out + O_SP + (size_t)(b * 4 + h) * 128 * 256;
    int lr2 = lr, g2 = g; asm volatile("" : "+v"(lr2), "+v"(g2));
#pragma unroll
    for (int mt = 0; mt < 8; ++mt)
#pragma unroll
        for (int i = 0; i < 4; ++i) so[(size_t)(16 * mt + 4 * g2 + i) * 256 + dv0 + lr2] = S[mt][i];
    BLOCK_SYNC();
}

__device__ __forceinline__ void gla_finish(const Args& a, Frame& F) {
    bf16_t* Z = (bf16_t*)(a.ws + WS_Z);
    const bf16_t* ORAW = (const bf16_t*)(a.ws + WS_B2);
    const float* SQP = (const float*)((unsigned char*)a.out + YO_SQP);
    const int gw = F.vcu * NWAVES + F.wave, NGW = F.G * NWAVES, lane = F.lane, hd = lane >> 4;
    f32x4 gg[4];
#pragma unroll
    for (int j = 0; j < 4; ++j) gg[j] = *(const f32x4*)(a.in[12] + 16 * lane + 4 * j);
    for (int m = gw; m < TP; m += NGW) {
        const f32x4* sp = (const f32x4*)(SQP + ((size_t)m * 4 + hd) * 16);
        const f32x4 s0 = sp[0], s1 = sp[1], s2 = sp[2], s3 = sp[3];
        const u32x4 oa0 = *(const u32x4*)(ORAW + (size_t)m * DM + 16 * lane), oa1 = *(const u32x4*)(ORAW + (size_t)m * DM + 16 * lane + 8);
        u32x4* rp = (u32x4*)(Z + (size_t)m * ZP + ZRA + 16 * lane);
        const u32x4 r0 = rp[0], r1 = rp[1];
        const float tot = ((s0.x + s0.y) + (s0.z + s0.w)) + ((s1.x + s1.y) + (s1.z + s1.w)) + ((s2.x + s2.y) + (s2.z + s2.w)) + ((s3.x + s3.y) + (s3.z + s3.w));
        const float rstd = 1.0f / sqrtf(tot * (1.0f / 256.0f) + EPS);
        const unsigned ow[8] = {oa0.x, oa0.y, oa0.z, oa0.w, oa1.x, oa1.y, oa1.z, oa1.w};
        const unsigned rw[8] = {r0.x, r0.y, r0.z, r0.w, r1.x, r1.y, r1.z, r1.w};
        unsigned res[8];
#pragma unroll
        for (int q = 0; q < 8; ++q) {
            const float ra = lo2f(rw[q]), rb = hi2f(rw[q]);
            const float va = lo2f(ow[q]) * rstd * gg[q >> 1][(q & 1) * 2] * (ra * fsigmoid(ra));
            const float vb = hi2f(ow[q]) * rstd * gg[q >> 1][(q & 1) * 2 + 1] * (rb * fsigmoid(rb));
            res[q] = pk2(va, vb);
        }
        rp[0] = (u32x4){res[0], res[1], res[2], res[3]}; rp[1] = (u32x4){res[4], res[5], res[6], res[7]};
    }
}

__device__ __forceinline__ void gla_sample_item(const Args& a, Frame& F, int bs, int h) {
    bf16_t* Z = (bf16_t*)(a.ws + WS_Z);
    const float* alr = (const float*)((unsigned char*)a.out + YO_ALR);
    const size_t row0 = (size_t)TP + 32 * bs;
    LAS float* GA = (LAS float*)(F.lds);
    LAS float* KL = (LAS float*)(F.lds + 16384);
    LAS float* QL = (LAS float*)(F.lds + 32768);
    LAS float* OL = (LAS float*)(F.lds + 49152);
    const int tid = F.tid;
    {
        const int c = tid & 127, tg = tid >> 7;
        float wv[16];
#pragma unroll
        for (int r = 0; r < 16; ++r) wv[r] = a.in[10][(size_t)r * 512 + h * 128 + c];
        const float bb = a.in[11][h * 128 + c];
#pragma unroll
        for (int i = 0; i < 8; ++i) {
            const int t = tg * 8 + i; float d = bb;
#pragma unroll
            for (int r = 0; r < 16; ++r) d += alr[(row0 + t) * 16 + r] * wv[r];
            GA[t * 128 + c] = __builtin_amdgcn_exp2f(log_sigmoid(d) * (LOG2E / 16.0f));
            KL[t * 128 + c] = bf2f(Z[(row0 + t) * ZP + ZKA + h * 128 + c]);
            QL[t * 128 + c] = bf2f(Z[(row0 + t) * ZP + ZQA + h * 128 + c]);
        }
    }
    BLOCK_SYNC();
    {
        const int dv = tid & 255, kh = tid >> 8;
        const float* s0 = a.in[4] + ((size_t)(bs * 4 + h) * 128 + kh * 64) * 256 + dv;
        float S[64];
#pragma unroll
        for (int i = 0; i < 64; ++i) S[i] = s0[(size_t)i * 256];
        for (int t = 0; t < 32; ++t) {
            const float v = bf2f(Z[(row0 + t) * ZP + ZVA + h * 256 + dv]);
            float acc = 0.f;
#pragma unroll
            for (int i4 = 0; i4 < 16; ++i4) {
                const f32x4 ga = *(const LAS f32x4*)(GA + t * 128 + kh * 64 + 4 * i4), kk = *(const LAS f32x4*)(KL + t * 128 + kh * 64 + 4 * i4), qq = *(const LAS f32x4*)(QL + t * 128 + kh * 64 + 4 * i4);
#pragma unroll
                for (int e = 0; e < 4; ++e) { S[4 * i4 + e] = ga[e] * S[4 * i4 + e] + kk[e] * v; acc += qq[e] * S[4 * i4 + e]; }
            }
            OL[(t * 2 + kh) * 256 + dv] = acc;
        }
        float* so = a.out + O_SS + ((size_t)(bs * 4 + h) * 128 + kh * 64) * 256 + dv;
#pragma unroll
        for (int i = 0; i < 64; ++i) so[(size_t)i * 256] = S[i];
    }
    BLOCK_SYNC();
    {
        const float* ggla = a.in[12] + h * 256;
        const f32x4 gg = *(const f32x4*)(ggla + 4 * F.lane);
#pragma unroll
        for (int i = 0; i < 4; ++i) {
            const int t = F.wave * 4 + i;
            const f32x4 o0 = *(const LAS f32x4*)(OL + (t * 2) * 256 + 4 * F.lane), o1 = *(const LAS f32x4*)(OL + (t * 2 + 1) * 256 + 4 * F.lane);
            const f32x4 o = o0 + o1;
            const float ss = wave_sum((o.x * o.x + o.y * o.y) + (o.z * o.z + o.w * o.w));
            const float rstd = 1.0f / sqrtf(ss * (1.0f / 256.0f) + EPS);
            u32x2* rp = (u32x2*)(Z + (row0 + t) * ZP + ZRA + h * 256 + 4 * F.lane);
            const u32x2 rr = *rp;
            const float r0 = lo2f(rr.x), r1 = hi2f(rr.x), r2 = lo2f(rr.y), r3 = hi2f(rr.y);
            u32x2 wv; wv.x = pk2(o.x * rstd * gg.x * (r0 * fsigmoid(r0)), o.y * rstd * gg.y * (r1 * fsigmoid(r1)));
            wv.y = pk2(o.z * rstd * gg.z * (r2 * fsigmoid(r2)), o.w * rstd * gg.w * (r3 * fsigmoid(r3)));
            *rp = wv;
        }
    }
    BLOCK_SYNC();
}

__device__ __forceinline__ void attn_unit(const Args& a, Frame& F, int kind, int b, int h, int qg) {
    bf16_t* Z = (bf16_t*)(a.ws + WS_Z);
    LAS bf16_t* KS = (LAS bf16_t*)(F.lds);
    LAS bf16_t* VT = (LAS bf16_t*)(F.lds + 18432);
    LAS float* BI = (LAS float*)(F.lds + 36864);
    const int tid = F.tid, lane = F.lane, w = F.wave, lr = lane & 15, g = lane >> 4;
    const int kt_lo = kind == 0 ? (4 * qg - 8 > 0 ? 4 * qg - 8 : 0) : 0, kt_hi = kind == 0 ? 4 * qg + 3 : 8;
    const bool wact = (kind == 0) || (w == 0);
    const int cq = 4 * qg + (w >> 1);
    const size_t qrow0 = kind == 0 ? (size_t)b * SEQ + 256 * qg + 32 * w : (size_t)TP + 32 * b;
    const int qpos0 = kind == 0 ? 256 * qg + 32 * w : 4096;
    for (int i = tid; i < 257; i += NTHR) BI[i] = a.in[13][h * 257 + i] * LOG2E;
    bf16x8 Qf[2][2];
#pragma unroll
    for (int nt = 0; nt < 2; ++nt)
#pragma unroll
        for (int ks = 0; ks < 2; ++ks) Qf[nt][ks] = wact ? *(const bf16x8*)(Z + (qrow0 + 16 * nt + lr) * ZP + ZQB + h * 64 + 32 * ks + 8 * g) : (bf16x8){0, 0, 0, 0, 0, 0, 0, 0};
    float mrun[2] = {-1e30f, -1e30f}, lrun[2] = {0.f, 0.f};
    f32x4 O[4][2];
#pragma unroll
    for (int md = 0; md < 4; ++md) { O[md][0] = (f32x4){0.f, 0.f, 0.f, 0.f}; O[md][1] = (f32x4){0.f, 0.f, 0.f, 0.f}; }
    const int lj = tid >> 3, ld8 = (tid & 7) * 8;
    u32x4 kreg, vreg;
#define AT_LOAD(kt) do { \
        if (kind == 0) { const size_t r_ = (size_t)b * SEQ + 64 * (kt) + lj; kreg = *(const u32x4*)(Z + r_ * ZP + ZKB + h * 64 + ld8); vreg = *(const u32x4*)(Z + r_ * ZP + ZVB + h * 64 + ld8); } \
        else if ((kt) < 8) { const size_t o_ = ((size_t)(b * 512 + 64 * (kt) + lj) * 8 + h) * 64 + ld8; \
            const f32x4 k0_ = *(const f32x4*)(a.in[2] + o_), k1_ = *(const f32x4*)(a.in[2] + o_ + 4), v0_ = *(const f32x4*)(a.in[3] + o_), v1_ = *(const f32x4*)(a.in[3] + o_ + 4); \
            kreg.x = pk2(k0_.x, k0_.y); kreg.y = pk2(k0_.z, k0_.w); kreg.z = pk2(k1_.x, k1_.y); kreg.w = pk2(k1_.z, k1_.w); \
            vreg.x = pk2(v0_.x, v0_.y); vreg.y = pk2(v0_.z, v0_.w); vreg.z = pk2(v1_.x, v1_.y); vreg.w = pk2(v1_.z, v1_.w); } \
        else if (lj < 32) { const size_t r_ = (size_t)TP + 32 * b + lj; kreg = *(const u32x4*)(Z + r_ * ZP + ZKB + h * 64 + ld8); vreg = *(const u32x4*)(Z + r_ * ZP + ZVB + h * 64 + ld8); } \
        else { kreg = (u32x4){0u, 0u, 0u, 0u}; vreg = (u32x4){0u, 0u, 0u, 0u}; } } while (0)
#define AT_STORE(bufi) do { *(LAS u32x4*)(KS + (bufi) * 4608 + lj * 72 + ld8) = kreg; \
        LAS bf16_t* vt_ = VT + (bufi) * 4608 + ld8 * 72 + lj; \
        vt_[0] = (bf16_t)(vreg.x & 0xffffu); vt_[72] = (bf16_t)(vreg.x >> 16); vt_[144] = (bf16_t)(vreg.y & 0xffffu); vt_[216] = (bf16_t)(vreg.y >> 16); \
        vt_[288] = (bf16_t)(vreg.z & 0xffffu); vt_[360] = (bf16_t)(vreg.z >> 16); vt_[432] = (bf16_t)(vreg.w & 0xffffu); vt_[504] = (bf16_t)(vreg.w >> 16); } while (0)
    AT_LOAD(kt_lo); AT_STORE(0);
    BLOCK_SYNC();
    for (int kt = kt_lo; kt <= kt_hi; ++kt) {
        const int bi = (kt - kt_lo) & 1;
        if (kt < kt_hi) AT_LOAD(kt + 1);
        const bool act = wact && (kind == 1 || (kt >= cq - 8 && kt <= cq));
        if (act) {
            const int kpos0 = kind == 0 ? 64 * kt : (kt < 8 ? 3584 + 64 * kt : 4096);
            const int nvalid = (kind == 1 && kt == 8) ? 32 : 64;
            const LAS bf16_t* Kb = KS + bi * 4608; const LAS bf16_t* Vb = VT + bi * 4608;
            f32x4 St[4][2];
#pragma unroll
            for (int mt = 0; mt < 4; ++mt) { St[mt][0] = (f32x4){0.f, 0.f, 0.f, 0.f}; St[mt][1] = (f32x4){0.f, 0.f, 0.f, 0.f}; }
#pragma unroll
            for (int ks = 0; ks < 2; ++ks)
#pragma unroll
                for (int mt = 0; mt < 4; ++mt) {
                    const bf16x8 kf = *(const LAS bf16x8*)(Kb + (16 * mt + lr) * 72 + 32 * ks + 8 * g);
                    St[mt][0] = __builtin_amdgcn_mfma_f32_16x16x32_bf16(kf, Qf[0][ks], St[mt][0], 0, 0, 0);
                    St[mt][1] = __builtin_amdgcn_mfma_f32_16x16x32_bf16(kf, Qf[1][ks], St[mt][1], 0, 0, 0);
                }
            const int d0 = qpos0 - kpos0;
            if (d0 >= 191) {
                const float cb = BI[256];
#pragma unroll
                for (int mt = 0; mt < 4; ++mt) { St[mt][0] = St[mt][0] + cb; St[mt][1] = St[mt][1] + cb; }
            } else {
#pragma unroll
                for (int mt = 0; mt < 4; ++mt)
#pragma unroll
                    for (int nt = 0; nt < 2; ++nt)
#pragma unroll
                        for (int i = 0; i < 4; ++i) {
                            int dist = d0 + (16 * nt + lr) - (16 * mt + 4 * g + i);
                            dist = dist < -128 ? -128 : (dist > 128 ? 128 : dist);
                            St[mt][nt][i] += BI[dist + 128];
                        }
            }
            if (nvalid < 64) {
#pragma unroll
                for (int mt = 0; mt < 4; ++mt)
#pragma unroll
                    for (int i = 0; i < 4; ++i) if (16 * mt + 4 * g + i >= nvalid) { St[mt][0][i] = -1e30f; St[mt][1][i] = -1e30f; }
            }
#pragma unroll
            for (int nt = 0; nt < 2; ++nt) {
                float tm = -1e30f;
#pragma unroll
                for (int mt = 0; mt < 4; ++mt)
#pragma unroll
                    for (int i = 0; i < 4; ++i) tm = fmaxf(tm, St[mt][nt][i]);
                tm = fmaxf(tm, __shfl_xor(tm, 16)); tm = fmaxf(tm, __shfl_xor(tm, 32));
                const float mnew = fmaxf(mrun[nt], tm);
                const float sc = __builtin_amdgcn_exp2f(mrun[nt] - mnew);
                mrun[nt] = mnew;
                float ps = 0.f;
#pragma unroll
                for (int mt = 0; mt < 4; ++mt)
#pragma unroll
                    for (int i = 0; i < 4; ++i) { const float p = __builtin_amdgcn_exp2f(St[mt][nt][i] - mnew); St[mt][nt][i] = p; ps += p; }
                lrun[nt] = lrun[nt] * sc + ps;
#pragma unroll
                for (int md = 0; md < 4; ++md) O[md][nt] = O[md][nt] * sc;
            }
#pragma unroll
            for (int ks = 0; ks < 2; ++ks) {
                bf16x8 pf[2];
#pragma unroll
                for (int nt = 0; nt < 2; ++nt) { u32x4 t; t.x = pk2(St[2 * ks][nt][0], St[2 * ks][nt][1]); t.y = pk2(St[2 * ks][nt][2], St[2 * ks][nt][3]); t.z = pk2(St[2 * ks + 1][nt][0], St[2 * ks + 1][nt][1]); t.w = pk2(St[2 * ks + 1][nt][2], St[2 * ks + 1][nt][3]); pf[nt] = __builtin_bit_cast(bf16x8, t); }
#pragma unroll
                for (int md = 0; md < 4; ++md) {
                    const u32x2 lo = *(const LAS u32x2*)(Vb + (16 * md + lr) * 72 + 32 * ks + 4 * g), hi = *(const LAS u32x2*)(Vb + (16 * md + lr) * 72 + 32 * ks + 16 + 4 * g);
                    u32x4 t; t.x = lo.x; t.y = lo.y; t.z = hi.x; t.w = hi.y;
                    const bf16x8 vf = __builtin_bit_cast(bf16x8, t);
                    O[md][0] = __builtin_amdgcn_mfma_f32_16x16x32_bf16(vf, pf[0], O[md][0], 0, 0, 0);
                    O[md][1] = __builtin_amdgcn_mfma_f32_16x16x32_bf16(vf, pf[1], O[md][1], 0, 0, 0);
                }
            }
        }
        if (kt < kt_hi) AT_STORE(bi ^ 1);
        BLOCK_SYNC();
    }
#undef AT_LOAD
#undef AT_STORE
    if (wact) {
#pragma unroll
        for (int nt = 0; nt < 2; ++nt) {
            float l = lrun[nt]; l += __shfl_xor(l, 16); l += __shfl_xor(l, 32);
            const float inv = 1.0f / l;
#pragma unroll
            for (int md = 0; md < 4; ++md) {
                u32x2 wv; wv.x = pk2(O[md][nt][0] * inv, O[md][nt][1] * inv); wv.y = pk2(O[md][nt][2] * inv, O[md][nt][3] * inv);
                *(u32x2*)(Z + (qrow0 + 16 * nt + lr) * ZP + ZQB + h * 64 + 16 * md + 4 * g) = wv;
            }
        }
    }
}

__device__ __forceinline__ void grid_bar(unsigned* ctr, unsigned target) {
    asm volatile("s_waitcnt vmcnt(0) lgkmcnt(0)" ::: "memory");
    __syncthreads();
    if (threadIdx.x == 0) {
        __builtin_amdgcn_fence(__ATOMIC_RELEASE, "agent");
        asm volatile("s_waitcnt vmcnt(0)" ::: "memory");
        __hip_atomic_fetch_add(ctr, 1u, __ATOMIC_RELAXED, __HIP_MEMORY_SCOPE_AGENT);
        unsigned spins = 0;
        while (__hip_atomic_load(ctr, __ATOMIC_RELAXED, __HIP_MEMORY_SCOPE_AGENT) < target) { __builtin_amdgcn_s_sleep(2); if (++spins > (1u << 24)) break; }
        __builtin_amdgcn_fence(__ATOMIC_ACQUIRE, "agent");
        asm volatile("s_waitcnt vmcnt(0)" ::: "memory");
    }
    __syncthreads();
}

__global__ void __launch_bounds__(NTHR, 2) fwd_megakernel(Args a) {
    extern __shared__ __attribute__((aligned(16))) unsigned char lds_raw[];
    cg::grid_group grid = cg::this_grid();
    Frame F;
    F.lds = (LAS unsigned char*)lds_raw;
    F.tid = threadIdx.x; F.lane = F.tid & 63; F.wave = __builtin_amdgcn_readfirstlane(F.tid >> 6);
    F.G = gridDim.x; { const int bx = blockIdx.x; F.vcu = (F.G % 8 == 0) ? (bx % 8) * (F.G / 8) + bx / 8 : bx; }
    unsigned char* ws = a.ws; unsigned char* yo = (unsigned char*)a.out;
    bf16_t* Z = (bf16_t*)(ws + WS_Z);
    bf16_t* B1 = (bf16_t*)(yo + YO_B1); bf16_t* B2 = (bf16_t*)(ws + WS_B2); bf16_t* B3 = (bf16_t*)(ws + WS_B3);
    float* SSQ = (float*)(ws + WS_SSQ);
    const int lo = a.ph_lo, hi = a.ph_hi;
#define IN(k) (lo <= (k) && (k) < hi)
#define SEAM(k) do { if (IN(k) && IN((k) + 1)) { if ((k) == 0) grid.sync(); else grid_bar((unsigned*)(ws + WS_CTL) + 64 * (k), (unsigned)F.G); } } while (0)
    pg8::StaticOrder S;

    fresh(F);
    if (IN(0)) p0_prologue(a, F);
    SEAM(0);
    for (int rep_ = 0; rep_ < PROBE_REP1; ++rep_)
    if (IN(1)) {
        pg8::Gemm g{B1, (const bf16_t*)(ws + WS_WIN), DM, DM, 0}; S.init(257, 27, F.G, (int)blockIdx.x);
        pg8::EpiZ E{Z, (float*)(yo + YO_ALR), a.out};
        pg8::gemm_phase(F.lds, g, S, E);
    }
    SEAM(1);
    fresh(F);
    if (IN(2)) { for (int it = F.vcu; it < 4096; it += F.G) gla_prepass_item(a, F, it); }
    SEAM(2);
    fresh(F);
    if (IN(3)) {
        if (F.vcu < 64) gla_chain(a, F, F.vcu >> 3, (F.vcu >> 1) & 3, F.vcu & 1);
        else {
            const int ab = F.vcu - 64, NA = F.G - 64;
            if (ab < 32) gla_sample_item(a, F, ab >> 2, ab & 3);
            for (int u = ab; u < 64 + 2048; u += NA) {
                if (u < 64) attn_unit(a, F, 1, u >> 3, u & 7, 0);
                else { const int v = u - 64; attn_unit(a, F, 0, v >> 8, (v >> 5) & 7, v & 31); }
            }
        }
    }
    SEAM(3);
    fresh(F);
    if (IN(4)) gla_finish(a, F);
    SEAM(4);
    if (IN(5)) {
        { pg8::Gemm g{Z + ZRA, (const bf16_t*)(ws + WS_WBRA), ZP, 1024, 0}; S.init(257, 4, F.G, (int)blockIdx.x);
          pg8::EpiEw<1> E{B1, DM, Z + ZGA, ZP, nullptr, 0, nullptr}; pg8::gemm_phase(F.lds, g, S, E); }
        { pg8::Gemm g{Z + ZQB, (const bf16_t*)(ws + WS_WBRB), ZP, 512, 0}; S.init(257, 4, F.G, (int)blockIdx.x);
          pg8::EpiEw<2> E{B1, DM, Z + ZGB, ZP, B1, DM, nullptr}; pg8::gemm_phase(F.lds, g, S, E); }
    }
    SEAM(5);
    if (IN(6)) {
        pg8::Gemm g{B1, (const bf16_t*)(ws + WS_WOUT), DM, 1024, 0}; S.init(257, 4, F.G, (int)blockIdx.x);
        pg8::EpiEw<3> E{B2, DM, nullptr, 0, nullptr, 0, SSQ}; pg8::gemm_phase(F.lds, g, S, E);
    }
    SEAM(6);
    fresh(F);
    if (IN(7)) row_pass<true, false>(a, F, true, B2, SSQ, a.in[17], a.in[18], B3, nullptr);
    SEAM(7);
    for (int rep_ = 0; rep_ < PROBE_REP7; ++rep_)
    if (IN(8)) {
        pg8::Gemm g{B3, (const bf16_t*)(ws + WS_WUP), DM, 1024, 1}; S.init(265, 22, F.G, (int)blockIdx.x);
        pg8::EpiConv E{(bf16_t*)(ws + WS_ACT), a.in[20], a.in[21], a.in[5], a.out, (LAS float*)(F.lds + XB_OFF)};
        pg8::gemm_phase(F.lds, g, S, E);
    }
    SEAM(8);
    if (IN(9)) {
        pg8::Gemm g{(const bf16_t*)(ws + WS_ACT), (const bf16_t*)(ws + WS_WDN), DFF, DFF, 0}; S.init(257, 4, F.G, (int)blockIdx.x);
        pg8::EpiEw<3> E{B2, DM, nullptr, 0, nullptr, 0, SSQ}; pg8::gemm_phase(F.lds, g, S, E);
    }
    SEAM(9);
    fresh(F);
    if (IN(10)) row_pass<true, true>(a, F, false, B2, SSQ, a.in[23], a.in[24], B3, (bf16_t*)(ws + WS_PB));
    SEAM(10);
    if (IN(11)) {
        { pg8::Gemm g{(const bf16_t*)(ws + WS_PB), (const bf16_t*)(ws + WS_WPLE), 256, 256, 0}; S.init(257, 4, F.G, (int)blockIdx.x);
          pg8::EpiEw<0> E{(bf16_t*)(ws + WS_E), DM, nullptr, 0, nullptr, 0, nullptr}; pg8::gemm_phase(F.lds, g, S, E); }
        { pg8::Gemm g{B3, (const bf16_t*)(ws + WS_WPG), DM, 1024, 0}; S.init(257, 4, F.G, (int)blockIdx.x);
          pg8::EpiEw<4> E{B2, DM, (const bf16_t*)(ws + WS_E), DM, nullptr, 0, SSQ}; pg8::gemm_phase(F.lds, g, S, E); }
    }
    SEAM(11);
    fresh(F);
    if (IN(12)) row_pass<false, false>(a, F, false, B2, SSQ, a.in[27], nullptr, nullptr, nullptr);
#undef IN
#undef SEAM
}

extern "C" void kernel_launch(void* const* d_in, const int* in_sizes, int n_in, void* d_out, int out_size, void* d_ws, size_t ws_size, hipStream_t stream) {
    static int grid = 0;
    if (grid == 0) {
        if (n_in != 28 || ws_size < WS_NEED || out_size != 74014720) { fprintf(stderr, "kernel_launch: unexpected n_in %d / ws %zu / out %d\n", n_in, ws_size, out_size); grid = -1; return; }
        int dev = 0, cus = 0, per_cu = 0;
        hipGetDevice(&dev); hipDeviceGetAttribute(&cus, hipDeviceAttributeMultiprocessorCount, dev);
        if (hipFuncSetAttribute((const void*)fwd_megakernel, hipFuncAttributeMaxDynamicSharedMemorySize, LDS_BYTES) != hipSuccess) { fprintf(stderr, "kernel_launch: hipFuncSetAttribute failed\n"); grid = -1; return; }
        if (hipOccupancyMaxActiveBlocksPerMultiprocessor(&per_cu, (const void*)fwd_megakernel, NTHR, LDS_BYTES) != hipSuccess || per_cu < 1) { fprintf(stderr, "kernel_launch: occupancy query gives %d\n", per_cu); per_cu = 1; }
        (void)hipGetLastError();
        grid = cus;
        if (grid % 8 != 0 || grid < 64) { fprintf(stderr, "kernel_launch: unexpected CU count %d\n", cus); }
    }
    if (grid < 0) return;
    if (hipMemsetAsync((char*)d_ws + WS_CTL, 0, 4096, stream) != hipSuccess) { fprintf(stderr, "kernel_launch: memset failed\n"); return; }
    Args a{};
    for (int i = 0; i < 28; ++i) a.in[i] = (const float*)d_in[i];
    a.out = (float*)d_out; a.ws = (unsigned char*)d_ws; a.ph_lo = 0; a.ph_hi = 13;
    void* args[] = {&a};
    hipError_t e = hipLaunchCooperativeKernel((const void*)fwd_megakernel, dim3(grid), dim3(NTHR), args, LDS_BYTES, stream);
    if (e != hipSuccess) fprintf(stderr, "cooperative launch failed: %s (grid %d)\n", hipGetErrorString(e), grid);
}
```
